# Optimizing an MI355X kernel written in HIP

```python
import jax, jax.numpy as jnp
from jax import lax
import numpy as np

D_MODEL = 1024
BATCH = 32
SEQ = 256
DEPTH = 2
DEC_BATCH = 2
DEC_SEQ = 1024
PAST_LEN = 256

GRID_W = 64
HEAD_DIM = 64
N_EVEN = (DEPTH + 1) // 2
N_ODD = DEPTH // 2
H_A = 8
Q_RANK = 256
KV_RANK = 128
NOPE_A = 64
ROPE_A = 32
V_A = 64
QK_A = NOPE_A + ROPE_A
H_B = 8
NA_ROWS = 8
NA_COLS = 16
H_C = 8
KV_C = 2
H_D = 8
KV_D = 2
SWA_HALF = 128
QBLOCK = 128
ROPE_THETA = 10000.0
EPS = 1e-6
NEG_INF = -1e30
EVEN_SPLITS = (Q_RANK, KV_RANK, ROPE_A, H_A * V_A, H_B * HEAD_DIM, H_B * HEAD_DIM, H_B * HEAD_DIM, H_B * HEAD_DIM)
EVEN_IN = sum(EVEN_SPLITS)
EVEN_MIX = H_A * V_A + H_B * HEAD_DIM
ODD_SPLITS = (H_C * HEAD_DIM, KV_C * HEAD_DIM, KV_C * HEAD_DIM, H_C * HEAD_DIM, H_D * HEAD_DIM, KV_D * HEAD_DIM, KV_D * HEAD_DIM, H_D * HEAD_DIM)
ODD_IN = sum(ODD_SPLITS)
ODD_MIX = H_C * HEAD_DIM + H_D * HEAD_DIM

kernel_name = 'hybrid_diffusion_prefix_trunk_step'


def _split(z, sizes):
    out, off = [], 0
    for s in sizes:
        out.append(z[..., off:off + s])
        off += s
    return out


def _rmsnorm(x, g):
    xf = x.astype(jnp.float32)
    y = xf * lax.rsqrt(jnp.mean(xf * xf, axis=-1, keepdims=True) + EPS)
    return (y * g.astype(jnp.float32)).astype(x.dtype)


def _heads(x, n):
    b, s, _ = x.shape
    return x.reshape(b, s, n, -1).transpose(0, 2, 1, 3)


def _merge(o):
    b, h, s, d = o.shape
    return o.transpose(0, 2, 1, 3).reshape(b, s, h * d)


def _groups(q, kvh):
    b, h, s, d = q.shape
    return q.reshape(b, kvh, h // kvh, s, d)


def _axial_rope(s, rot_dim):
    quarter = rot_dim // 4
    t = jnp.arange(s)
    inv = ROPE_THETA ** (-jnp.arange(quarter, dtype=jnp.float32) / quarter)
    row = (t // GRID_W).astype(jnp.float32)[:, None] * inv
    col = (t % GRID_W).astype(jnp.float32)[:, None] * inv
    ang = jnp.concatenate([row, col], axis=-1)
    return jnp.cos(ang), jnp.sin(ang)


def _rope(x, cos, sin):
    half = x.shape[-1] // 2
    x1 = x[..., :half].astype(jnp.float32)
    x2 = x[..., half:].astype(jnp.float32)
    return jnp.concatenate([x1 * cos - x2 * sin, x1 * sin + x2 * cos], axis=-1).astype(x.dtype)


def _rope_tail(x, cos, sin, n):
    return jnp.concatenate([x[..., :-n], _rope(x[..., -n:], cos, sin)], axis=-1)


def _modulate(x, cond, g, w_mod, b_mod):
    m = jax.nn.silu(cond) @ w_mod + b_mod
    if m.ndim == 2:
        m = m[:, None, :]
    shift, scale, gate = jnp.split(m, 3, axis=-1)
    return _rmsnorm(x, g) * (1 + scale) + shift, gate


def _attend_blocked(q, parts, sink=None):
    b, kh, g, s, dk = q.shape
    bq = min(QBLOCK, s)
    nb = s // bq
    qb = jnp.moveaxis(q.reshape(b, kh, g, nb, bq, dk), 3, 0)
    lens = [k.shape[2] for k, _ in parts]

    def block(qi):
        sc = jnp.concatenate([jnp.einsum('bkgqd,bkld->bkgql', qi, k) for k, _ in parts], axis=-1).astype(jnp.float32)
        if sink is not None:
            sk = jnp.broadcast_to(sink.astype(jnp.float32)[None, :, :, None, None], sc.shape[:-1] + (1,))
            sc = jnp.concatenate([sc, sk], axis=-1)
        p = jax.nn.softmax(sc, axis=-1)
        out, off = None, 0
        for (k, v), ln in zip(parts, lens):
            o = jnp.einsum('bkgql,bkld->bkgqd', p[..., off:off + ln].astype(v.dtype), v)
            out = o if out is None else out + o
            off += ln
        return out

    o = lax.map(block, qb)
    return jnp.moveaxis(o, 0, 3).reshape(b, kh * g, s, -1)


def _neighbourhood(q, k, v, k_ctx, v_ctx, rpb):
    b, h, s, d = q.shape
    rows = s // GRID_W
    kr = min(NA_ROWS, rows)
    kc = NA_COLS
    ncb = GRID_W // kc
    halo = 2 * kc
    r = jnp.arange(rows)
    row_idx = jnp.clip(r - kr // 2, 0, rows - kr)[:, None] + jnp.arange(kr)[None, :]
    j = jnp.arange(ncb)
    col_idx = jnp.clip(j * kc - kc // 2, 0, GRID_W - halo)[:, None] + jnp.arange(halo)[None, :]
    qcol = j[:, None] * kc + jnp.arange(kc)[None, :]
    cs = jnp.clip(qcol - kc // 2, 0, GRID_W - kc)
    valid = (col_idx[:, None, :] >= cs[..., None]) & (col_idx[:, None, :] < cs[..., None] + kc)
    dr = row_idx - r[:, None] + (NA_ROWS - 1)
    dc = jnp.clip(col_idx[:, None, :] - qcol[..., None] + (kc - 1), 0, 2 * kc - 2)
    bias = rpb[:, dr[:, None, None, :, None], dc[None, :, :, None, :]].astype(jnp.float32)
    bias = jnp.where(valid[None, None, :, :, None, :], bias, NEG_INF)
    qg = q.reshape(b, h, rows, ncb, kc, d)
    ri = row_idx[:, None, :, None]
    ci = col_idx[None, :, None, :]
    kg = k.reshape(b, h, rows, GRID_W, d)[:, :, ri, ci]
    vg = v.reshape(b, h, rows, GRID_W, d)[:, :, ri, ci]
    s_lat = jnp.einsum('bhrjqd,bhrjkwd->bhrjqkw', qg, kg).astype(jnp.float32) + bias[None]
    nl = kr * halo
    s_lat = s_lat.reshape(b, h, rows, ncb, kc, nl)
    s_ctx = jnp.einsum('bhrjqd,bhcd->bhrjqc', qg, k_ctx).astype(jnp.float32)
    p = jax.nn.softmax(jnp.concatenate([s_lat, s_ctx], axis=-1), axis=-1)
    o = (jnp.einsum('bhrjqn,bhrjnd->bhrjqd', p[..., :nl].astype(v.dtype), vg.reshape(b, h, rows, ncb, nl, d))
         + jnp.einsum('bhrjqc,bhcd->bhrjqd', p[..., nl:].astype(v.dtype), v_ctx))
    return o.reshape(b, h, s, d)


def _windowed(q, k, v, k_ctx, v_ctx, sink):
    b, kh, g, s, d = q.shape
    w = SWA_HALF
    nb = s // w
    pad = ((0, 0), (0, 0), (w, w), (0, 0))
    kp = jnp.pad(k, pad).reshape(b, kh, nb + 2, w, d)
    vp = jnp.pad(v, pad).reshape(b, kh, nb + 2, w, d)
    kb = jnp.concatenate([kp[:, :, 0:nb], kp[:, :, 1:nb + 1], kp[:, :, 2:nb + 2]], axis=3)
    vb = jnp.concatenate([vp[:, :, 0:nb], vp[:, :, 1:nb + 1], vp[:, :, 2:nb + 2]], axis=3)
    qb = q.reshape(b, kh, g, nb, w, d)
    qpos = jnp.arange(s).reshape(nb, w)
    kpos = jnp.arange(nb)[:, None] * w - w + jnp.arange(3 * w)[None, :]
    valid = ((kpos[:, None, :] >= 0) & (kpos[:, None, :] < s)
             & (jnp.abs(qpos[:, :, None] - kpos[:, None, :]) <= w))
    s_loc = jnp.where(valid, jnp.einsum('bkgnqd,bknld->bkgnql', qb, kb).astype(jnp.float32), NEG_INF)
    s_ctx = jnp.einsum('bkgnqd,bkcd->bkgnqc', qb, k_ctx).astype(jnp.float32)
    sk = jnp.broadcast_to(sink.astype(jnp.float32)[None, :, :, None, None, None], s_loc.shape[:-1] + (1,))
    p = jax.nn.softmax(jnp.concatenate([s_loc, s_ctx, sk], axis=-1), axis=-1)
    nl = 3 * w
    nc = k_ctx.shape[2]
    o = (jnp.einsum('bkgnql,bknld->bkgnqd', p[..., :nl].astype(v.dtype), vb)
         + jnp.einsum('bkgnqc,bkcd->bkgnqd', p[..., nl:nl + nc].astype(v.dtype), v_ctx))
    return o.reshape(b, kh * g, s, d)


def _gated_out(o1, g1, o2, g2, w_out):
    y = jnp.concatenate([_merge(o1) * jax.nn.silu(g1), _merge(o2) * jax.nn.silu(g2)], axis=-1)
    return y @ w_out


def _even_project(h, w_in, qa_g, w_q_up, kva_g, q_g, na_q_g, na_k_g):
    q_lat, ckv, krope, gate_a, q_b, k_b, v_b, gate_b = _split(h @ w_in, EVEN_SPLITS)
    q_a = _rmsnorm(_heads(_rmsnorm(q_lat, qa_g) @ w_q_up, H_A), q_g)
    q_b = _rmsnorm(_heads(q_b, H_B), na_q_g)
    k_b = _rmsnorm(_heads(k_b, H_B), na_k_g)
    return q_a, _rmsnorm(ckv, kva_g), krope, gate_a, q_b, k_b, _heads(v_b, H_B), gate_b


def _mla_kv(ckv, krope, w_kv_up, k_g):
    kv = _heads(ckv @ w_kv_up, H_A)
    b, h, l, _ = kv.shape
    k = jnp.concatenate([kv[..., :NOPE_A], jnp.broadcast_to(krope[:, None], (b, h, l, ROPE_A))], axis=-1)
    return _rmsnorm(k, k_g), kv[..., NOPE_A:]


def _even_context(h, pe):
    w_in, qa_g, w_q_up, kva_g, w_kv_up, q_g, k_g, na_q_g, na_k_g, rpb, w_out = pe
    q_a, ckv, krope, gate_a, q_b, k_b, v_b, gate_b = _even_project(h, w_in, qa_g, w_q_up, kva_g, q_g, na_q_g, na_k_g)
    k_a, v_a = _mla_kv(ckv, krope, w_kv_up, k_g)
    o_a = _attend_blocked(_groups(q_a * QK_A ** -0.5, H_A), [(k_a, v_a)])
    o_b = _attend_blocked(_groups(q_b * HEAD_DIM ** -0.5, H_B), [(k_b, v_b)])
    return _gated_out(o_a, gate_a, o_b, gate_b, w_out), (ckv, krope, k_b, v_b)


def _even_latent(h, ckv_c, krope_c, k_b_c, v_b_c, pe):
    w_in, qa_g, w_q_up, kva_g, w_kv_up, q_g, k_g, na_q_g, na_k_g, rpb, w_out = pe
    q_a, ckv, krope, gate_a, q_b, k_b, v_b, gate_b = _even_project(h, w_in, qa_g, w_q_up, kva_g, q_g, na_q_g, na_k_g)
    cos, sin = _axial_rope(h.shape[1], ROPE_A)
    q_a = _rope_tail(q_a, cos, sin, ROPE_A)
    k_a, v_a = _mla_kv(ckv, krope, w_kv_up, k_g)
    k_a = _rope_tail(k_a, cos, sin, ROPE_A)
    k_ac, v_ac = _mla_kv(ckv_c, krope_c, w_kv_up, k_g)
    o_a = _attend_blocked(_groups(q_a * QK_A ** -0.5, H_A), [(k_a, v_a), (k_ac, v_ac)])
    o_b = _neighbourhood(q_b * HEAD_DIM ** -0.5, k_b, v_b, k_b_c, v_b_c, rpb)
    return _gated_out(o_a, gate_a, o_b, gate_b, w_out)


def _odd_project(h, w_in, gq_g, gk_g, sq_g, sk_g):
    qc, kc, vc, gc, qd, kd, vd, gd = _split(h @ w_in, ODD_SPLITS)
    return (_rmsnorm(_heads(qc, H_C), gq_g), _rmsnorm(_heads(kc, KV_C), gk_g), _heads(vc, KV_C), gc,
            _rmsnorm(_heads(qd, H_D), sq_g), _rmsnorm(_heads(kd, KV_D), sk_g), _heads(vd, KV_D), gd)


def _odd_context(h, po):
    w_in, gq_g, gk_g, sq_g, sk_g, sink, w_out = po
    qc, kc, vc, gc, qd, kd, vd, gd = _odd_project(h, w_in, gq_g, gk_g, sq_g, sk_g)
    sc = HEAD_DIM ** -0.5
    o_c = _attend_blocked(_groups(qc * sc, KV_C), [(kc, vc)])
    o_d = _attend_blocked(_groups(qd * sc, KV_D), [(kd, vd)], sink.reshape(KV_D, H_D // KV_D))
    return _gated_out(o_c, gc, o_d, gd, w_out), (kc, vc, kd, vd)


def _odd_latent(h, kc_c, vc_c, kd_c, vd_c, po):
    w_in, gq_g, gk_g, sq_g, sk_g, sink, w_out = po
    qc, kc, vc, gc, qd, kd, vd, gd = _odd_project(h, w_in, gq_g, gk_g, sq_g, sk_g)
    cos, sin = _axial_rope(h.shape[1], HEAD_DIM)
    qc, kc, qd, kd = _rope(qc, cos, sin), _rope(kc, cos, sin), _rope(qd, cos, sin), _rope(kd, cos, sin)
    sc = HEAD_DIM ** -0.5
    o_c = _attend_blocked(_groups(qc * sc, KV_C), [(kc, vc), (kc_c, vc_c)])
    o_d = _windowed(_groups(qd * sc, KV_D), kd, vd, kd_c, vd_c, sink.reshape(KV_D, H_D // KV_D))
    return _gated_out(o_c, gc, o_d, gd, w_out)


def setup_inputs(seed: int = 0) -> dict:
    key = jax.random.key(seed)
    ks = iter(jax.random.split(key, 48))

    def nrm(shape, scale):
        return jax.random.normal(next(ks), shape, jnp.float32) * scale

    def gain(shape):
        return 1.0 + nrm(shape, 0.01)

    return {
        'x_prompt': nrm((BATCH, SEQ, D_MODEL), 1.0),
        'x_sample': nrm((DEC_BATCH, DEC_SEQ, D_MODEL), 1.0),
        'cache_mla_ckv': nrm((DEC_BATCH, N_EVEN, PAST_LEN, KV_RANK), 1.0),
        'cache_mla_krope': nrm((DEC_BATCH, N_EVEN, PAST_LEN, ROPE_A), 1.0),
        'cache_na_k': nrm((DEC_BATCH, N_EVEN, H_B, PAST_LEN, HEAD_DIM), 1.0),
        'cache_na_v': nrm((DEC_BATCH, N_EVEN, H_B, PAST_LEN, HEAD_DIM), 1.0),
        'cache_gqa_k': nrm((DEC_BATCH, N_ODD, KV_C, PAST_LEN, HEAD_DIM), 1.0),
        'cache_gqa_v': nrm((DEC_BATCH, N_ODD, KV_C, PAST_LEN, HEAD_DIM), 1.0),
        'cache_swa_k': nrm((DEC_BATCH, N_ODD, KV_D, PAST_LEN, HEAD_DIM), 1.0),
        'cache_swa_v': nrm((DEC_BATCH, N_ODD, KV_D, PAST_LEN, HEAD_DIM), 1.0),
        'c': nrm((DEC_BATCH, D_MODEL), 1.0),
        'c_ctx': nrm((D_MODEL,), 1.0),
        'norm_g': gain((DEPTH, D_MODEL)),
        'w_mod': nrm((DEPTH, D_MODEL, 3 * D_MODEL), 0.5 * D_MODEL ** -0.5),
        'b_mod': nrm((DEPTH, 3 * D_MODEL), 0.01),
        'w_in_even': nrm((N_EVEN, D_MODEL, EVEN_IN), D_MODEL ** -0.5),
        'mla_qa_g': gain((N_EVEN, Q_RANK)),
        'w_q_up': nrm((N_EVEN, Q_RANK, H_A * QK_A), Q_RANK ** -0.5),
        'mla_kva_g': gain((N_EVEN, KV_RANK)),
        'w_kv_up': nrm((N_EVEN, KV_RANK, H_A * (NOPE_A + V_A)), KV_RANK ** -0.5),
        'mla_q_g': gain((N_EVEN, QK_A)),
        'mla_k_g': gain((N_EVEN, QK_A)),
        'na_q_g': gain((N_EVEN, HEAD_DIM)),
        'na_k_g': gain((N_EVEN, HEAD_DIM)),
        'na_rpb': nrm((N_EVEN, H_B, 2 * NA_ROWS - 1, 2 * NA_COLS - 1), 0.1),
        'w_out_even': nrm((N_EVEN, EVEN_MIX, D_MODEL), EVEN_MIX ** -0.5),
        'w_in_odd': nrm((N_ODD, D_MODEL, ODD_IN), D_MODEL ** -0.5),
        'gqa_q_g': gain((N_ODD, HEAD_DIM)),
        'gqa_k_g': gain((N_ODD, HEAD_DIM)),
        'swa_q_g': gain((N_ODD, HEAD_DIM)),
        'swa_k_g': gain((N_ODD, HEAD_DIM)),
        'swa_sink': nrm((N_ODD, H_D), 1.0),
        'w_out_odd': nrm((N_ODD, ODD_MIX, D_MODEL), ODD_MIX ** -0.5),
    }


def reference(x_prompt, x_sample, cache_mla_ckv, cache_mla_krope, cache_na_k, cache_na_v, cache_gqa_k, cache_gqa_v,
              cache_swa_k, cache_swa_v, c, c_ctx, norm_g, w_mod, b_mod, w_in_even, mla_qa_g, w_q_up, mla_kva_g,
              w_kv_up, mla_q_g, mla_k_g, na_q_g, na_k_g, na_rpb, w_out_even, w_in_odd, gqa_q_g, gqa_k_g, swa_q_g,
              swa_k_g, swa_sink, w_out_odd):
    xp, xs = x_prompt, x_sample
    st_e = ([], [], [], [])
    st_o = ([], [], [], [])
    for l in range(DEPTH):
        i = l // 2
        hp, gp = _modulate(xp, c_ctx, norm_g[l], w_mod[l], b_mod[l])
        hs, gs = _modulate(xs, c, norm_g[l], w_mod[l], b_mod[l])
        if l % 2 == 0:
            pe = (w_in_even[i], mla_qa_g[i], w_q_up[i], mla_kva_g[i], w_kv_up[i], mla_q_g[i], mla_k_g[i],
                  na_q_g[i], na_k_g[i], na_rpb[i], w_out_even[i])
            yp, ctx = _even_context(hp, pe)
            ys = _even_latent(hs, cache_mla_ckv[:, i], cache_mla_krope[:, i], cache_na_k[:, i], cache_na_v[:, i], pe)
            for lst, t in zip(st_e, ctx):
                lst.append(t)
        else:
            po = (w_in_odd[i], gqa_q_g[i], gqa_k_g[i], swa_q_g[i], swa_k_g[i], swa_sink[i], w_out_odd[i])
            yp, ctx = _odd_context(hp, po)
            ys = _odd_latent(hs, cache_gqa_k[:, i], cache_gqa_v[:, i], cache_swa_k[:, i], cache_swa_v[:, i], po)
            for lst, t in zip(st_o, ctx):
                lst.append(t)
        xp = xp + gp * yp
        xs = xs + gs * ys
    new_mla_ckv = jnp.stack(st_e[0], axis=1)
    new_mla_krope = jnp.stack(st_e[1], axis=1)
    new_na_k = jnp.stack(st_e[2], axis=1)
    new_na_v = jnp.stack(st_e[3], axis=1)
    new_gqa_k = jnp.stack(st_o[0], axis=1)
    new_gqa_v = jnp.stack(st_o[1], axis=1)
    new_swa_k = jnp.stack(st_o[2], axis=1)
    new_swa_v = jnp.stack(st_o[3], axis=1)
    return (xp, xs, new_mla_ckv, new_mla_krope, new_na_k, new_na_v, new_gqa_k, new_gqa_v, new_swa_k, new_swa_v)
```

```cpp
#include <hip/hip_runtime.h>
#include <hip/hip_cooperative_groups.h>
#include <cstdio>
#include <type_traits>
namespace cg = cooperative_groups;

typedef __attribute__((ext_vector_type(8))) __bf16 bf16x8;
typedef __attribute__((ext_vector_type(4))) float f32x4;
typedef unsigned short bfraw;

#ifndef MULTI_LAUNCH
#define MULTI_LAUNCH 0
#endif

#define T_CTX 8192
#define T_LAT 2048
#define T_ALL 10240
#define TP 10752
#define DM 1024
#define EPSF 1e-6f
#define LOG2E 1.4426950408889634f
#define LD0 3072
#define LD1 2560
#define C0_QB 0
#define C0_KB 512
#define C0_VB 1024
#define C0_GA 1536
#define C0_GB 2048
#define C0_QLAT 2560
#define C0_CKV 2816
#define C0_KROPE 2944
#define C1_QC 0
#define C1_KC 512
#define C1_VC 640
#define C1_GC 768
#define C1_QD 1280
#define C1_KD 1792
#define C1_VD 1920
#define C1_GD 2048

#define WS_WIN0   0ull
#define WS_WIN1   (WS_WIN0 + 3072ull*1024*2)
#define WS_WOUT0  (WS_WIN1 + 2560ull*1024*2)
#define WS_WOUT1  (WS_WOUT0 + 1024ull*1024*2)
#define WS_WQUP   (WS_WOUT1 + 1024ull*1024*2)
#define WS_WKVUP  (WS_WQUP + 768ull*256*2)
#define WS_MODF   (WS_WKVUP + 1024ull*128*2)
#define WS_COSA   (WS_MODF + 2ull*3*3072*4)
#define WS_SINA   (WS_COSA + 1024ull*16*4)
#define WS_COSH   (WS_SINA + 1024ull*16*4)
#define WS_SINH   (WS_COSH + 1024ull*32*4)
#define WS_HY     (WS_SINH + 1024ull*32*4)
#define WS_AX     (WS_HY + 10240ull*1024*2)
#define WS_VT     (WS_AX + 10752ull*3072*2)
#define WS_QA     (WS_VT + 1024ull*10752*2)
#define WS_KA     (WS_QA + 10240ull*768*2)
#define WS_KROPE  (WS_KA + 10752ull*768*2)
#define WS_QSS    (WS_KROPE + 10752ull*32*4)
#define WS_CKSS   (WS_QSS + 10240ull*4*4)
#define WS_WKVUP2 (WS_CKSS + 10240ull*2*4)
#define WS_KMAX   (WS_WKVUP2 + 1024ull*128*2)
#define WS_KH     (WS_KMAX + 256ull)
#define WS_X1     (WS_KH + 8ull*10752*64*2)
#define WS_BAR    (WS_X1 + 10240ull*1024*4)
#define WS_END    (WS_BAR + 16384ull)

#define O_YP   0ull
#define O_YS   8388608ull
#define O_CKV  10485760ull
#define O_KROPE 11534336ull
#define O_NAK  11796480ull
#define O_NAV  15990784ull
#define O_GQK  20185088ull
#define O_GQV  21233664ull
#define O_SWK  22282240ull
#define O_SWV  23330816ull

struct Params {
  const float* in[33];
  float* out;
  unsigned char* ws;
  int sync_mode;
  int pad_;
};
enum { I_XP = 0, I_XS, I_CCKV, I_CKROPE, I_CNAK, I_CNAV, I_CGQK, I_CGQV, I_CSWK, I_CSWV, I_C, I_CCTX, I_NORMG, I_WMOD, I_BMOD,
       I_WINE, I_QAG, I_WQUP, I_KVAG, I_WKVUP, I_MQG, I_MKG, I_NAQG, I_NAKG, I_RPB, I_WOUTE, I_WINO, I_GQG, I_GKG, I_SQG, I_SKG, I_SINK, I_WOUTO };

__device__ __forceinline__ bfraw f2bf(float f) { __bf16 h = (__bf16)f; return __builtin_bit_cast(bfraw, h); }
typedef __attribute__((ext_vector_type(2))) float f32x2_t;
typedef __attribute__((ext_vector_type(2))) __bf16 bf16x2_t;
__device__ __forceinline__ unsigned pack2(float a, float b) { const f32x2_t v = {a, b}; return __builtin_bit_cast(unsigned, __builtin_convertvector(v, bf16x2_t)); }
__device__ __forceinline__ float bf2f(unsigned h) { return __uint_as_float(h << 16); }
__device__ __forceinline__ float silu_f(float x) { return x / (1.f + __expf(-x)); }
__device__ __forceinline__ float quad_sum(float v) { v += __shfl_xor(v, 16); v += __shfl_xor(v, 32); return v; }
__device__ __forceinline__ float quad_max(float v) { v = fmaxf(v, __shfl_xor(v, 16)); v = fmaxf(v, __shfl_xor(v, 32)); return v; }
__device__ __forceinline__ f32x4 mfma16(bf16x8 a, bf16x8 b, f32x4 c) { return __builtin_amdgcn_mfma_f32_16x16x32_bf16(a, b, c, 0, 0, 0); }
__device__ __forceinline__ uint2 pack4(f32x4 v) { uint2 u; u.x = pack2(v[0], v[1]); u.y = pack2(v[2], v[3]); return u; }

#define VCHUNKS 168
__device__ __forceinline__ size_t vc_off(int head, int tok, int f) { return (((size_t)head * VCHUNKS + (tok >> 6)) * 64 + f) * 64 + (tok & 63); }
__device__ __forceinline__ f32x4 ld_nt4(const float* p) { return __builtin_nontemporal_load((const f32x4*)p); }
__device__ __forceinline__ void st_nt4(float* p, f32x4 v) { __builtin_nontemporal_store(v, (f32x4*)p); }
__device__ __forceinline__ f32x4 ld_bf16x4(const bfraw* p) {
  const uint2 u = *(const uint2*)p;
  return f32x4{bf2f(u.x & 0xffffu), bf2f(u.x >> 16), bf2f(u.y & 0xffffu), bf2f(u.y >> 16)};
}
#define LDSK 64
#define NT 512
#define LDS_BYTES 131072

__device__ __forceinline__ int phase_tid() { int t = threadIdx.x; asm volatile("" : "+v"(t)); return t; }

template <int TN, int TM, int WN, int WM>
__device__ __forceinline__ void gemm_mainloop(const bfraw* __restrict__ Wt, int ldw, const bfraw* __restrict__ Act, int lda,
                                              int n0, int m0, int K, bfraw* lds, f32x4 (&acc)[TN][TM]) {
  static_assert(WN * WM == 8, "8 waves");
  constexpr int BN = TN * WN * 16, BM = TM * WM * 16;
  constexpr int NCW = (BN * 8 + NT - 1) / NT, NCA = (BM * 8 + NT - 1) / NT;
  const int tid = phase_tid(), lane = tid & 63, wave = tid >> 6;
  const int wn = wave % WN, wm = wave / WN;
  const int r16 = lane & 15, q4 = lane >> 4;
  bfraw* ldsW = lds;
  bfraw* ldsA = lds + 2 * BN * LDSK;
#pragma unroll
  for (int i = 0; i < TN; ++i)
#pragma unroll
    for (int j = 0; j < TM; ++j) acc[i][j] = f32x4{0.f, 0.f, 0.f, 0.f};
  uint4 rw[NCW], ra[NCA];
  const int KT = K / 64;
  auto gload = [&](int k0) {
#pragma unroll
    for (int i = 0; i < NCW; ++i) { int c = tid + NT * i; if (c >= BN * 8) c = BN * 8 - 1; int row = c >> 3, kc = c & 7; rw[i] = *(const uint4*)(Wt + (size_t)(n0 + row) * ldw + k0 + kc * 8); }
#pragma unroll
    for (int i = 0; i < NCA; ++i) { int c = tid + NT * i; if (c >= BM * 8) c = BM * 8 - 1; int row = c >> 3, kc = c & 7; ra[i] = *(const uint4*)(Act + (size_t)(m0 + row) * lda + k0 + kc * 8); }
  };
  auto lstore = [&](int buf) {
#pragma unroll
    for (int i = 0; i < NCW; ++i) { int c = tid + NT * i; if (c < BN * 8) { int row = c >> 3, kc = (c & 7) ^ ((row >> 1) & 7); *(uint4*)(ldsW + (buf * BN + row) * LDSK + kc * 8) = rw[i]; } }
#pragma unroll
    for (int i = 0; i < NCA; ++i) { int c = tid + NT * i; if (c < BM * 8) { int row = c >> 3, kc = (c & 7) ^ ((row >> 1) & 7); *(uint4*)(ldsA + (buf * BM + row) * LDSK + kc * 8) = ra[i]; } }
  };
  __syncthreads();
  gload(0);
  lstore(0);
  __syncthreads();
  for (int kt = 0; kt < KT; ++kt) {
    const int buf = kt & 1;
    gload(((kt + 1 < KT) ? kt + 1 : kt) * 64);
    const bfraw* bw = ldsW + (buf * BN + wn * TN * 16 + r16) * LDSK;
    const bfraw* ba = ldsA + (buf * BM + wm * TM * 16 + r16) * LDSK;
#pragma unroll
    for (int ks = 0; ks < 2; ++ks) {
      bf16x8 fw[TN], fa[TM];
      const int sw = ((ks * 4 + q4) ^ (r16 >> 1)) * 8;
#pragma unroll
      for (int i = 0; i < TN; ++i) fw[i] = *(const bf16x8*)(bw + i * 16 * LDSK + sw);
#pragma unroll
      for (int j = 0; j < TM; ++j) fa[j] = *(const bf16x8*)(ba + j * 16 * LDSK + sw);
#pragma unroll
      for (int i = 0; i < TN; ++i)
#pragma unroll
        for (int j = 0; j < TM; ++j) acc[i][j] = mfma16(fw[i], fa[j], acc[i][j]);
    }
    lstore(buf ^ 1);
    __syncthreads();
  }
}

template <int I, int N, class F>
__device__ __forceinline__ void static_for(F&& f) { if constexpr (I < N) { f(std::integral_constant<int, I>{}); static_for<I + 1, N>(f); } }

template <int TN, int TM, int WN, int WM, int KT>
__device__ __forceinline__ void gemm_smallk(const bfraw* __restrict__ Wt, int ldw, const bfraw* __restrict__ Act, int lda,
                                            int n0, int m0, bfraw* lds, f32x4 (&acc)[TN][TM]) {
  static_assert(WN * WM == 8, "8 waves");
  constexpr int BN = TN * WN * 16, BM = TM * WM * 16;
  constexpr int NCW = (BN * 8 + NT - 1) / NT, NCA = (BM * 8 + NT - 1) / NT;
  const int tid = phase_tid(), lane = tid & 63, wave = tid >> 6;
  const int wn = wave % WN, wm = wave / WN;
  const int r16 = lane & 15, q4 = lane >> 4;
  bfraw* ldsW = lds;
  bfraw* ldsA = lds + 2 * BN * LDSK;
#pragma unroll
  for (int i = 0; i < TN; ++i)
#pragma unroll
    for (int j = 0; j < TM; ++j) acc[i][j] = f32x4{0.f, 0.f, 0.f, 0.f};
  static_assert(NCW == 2 && NCA == 4, "two W chunks and four A chunks per thread");
  uint4 w00, w01, a00, a01, a02, a03, w10, w11, a10, a11, a12, a13;
  auto ldw1 = [&](int kt, int i) -> uint4 { int c = tid + NT * i; if (c >= BN * 8) c = BN * 8 - 1; const int row = c >> 3, kc = c & 7; return *(const uint4*)(Wt + (size_t)(n0 + row) * ldw + kt * 64 + kc * 8); };
  auto lda1 = [&](int kt, int i) -> uint4 { const int c = tid + NT * i; const int row = c >> 3, kc = c & 7; return *(const uint4*)(Act + (size_t)(m0 + row) * lda + kt * 64 + kc * 8); };
  auto stw1 = [&](int buf, int i, const uint4& v) { const int c = tid + NT * i; if (c < BN * 8) { const int row = c >> 3, kc = (c & 7) ^ ((row >> 1) & 7); *(uint4*)(ldsW + (buf * BN + row) * LDSK + kc * 8) = v; } };
  auto sta1 = [&](int buf, int i, const uint4& v) { const int c = tid + NT * i; const int row = c >> 3, kc = (c & 7) ^ ((row >> 1) & 7); *(uint4*)(ldsA + (buf * BM + row) * LDSK + kc * 8) = v; };
#define SK_LOAD0(kt) do { w00 = ldw1(kt, 0); w01 = ldw1(kt, 1); a00 = lda1(kt, 0); a01 = lda1(kt, 1); a02 = lda1(kt, 2); a03 = lda1(kt, 3); } while (0)
#define SK_LOAD1(kt) do { w10 = ldw1(kt, 0); w11 = ldw1(kt, 1); a10 = lda1(kt, 0); a11 = lda1(kt, 1); a12 = lda1(kt, 2); a13 = lda1(kt, 3); } while (0)
#define SK_STAGE0(buf) do { stw1(buf, 0, w00); stw1(buf, 1, w01); sta1(buf, 0, a00); sta1(buf, 1, a01); sta1(buf, 2, a02); sta1(buf, 3, a03); } while (0)
#define SK_STAGE1(buf) do { stw1(buf, 0, w10); stw1(buf, 1, w11); sta1(buf, 0, a10); sta1(buf, 1, a11); sta1(buf, 2, a12); sta1(buf, 3, a13); } while (0)
#define SK_COMPUTE(buf) do { \
    const bfraw* bw = ldsW + ((buf) * BN + wn * TN * 16 + r16) * LDSK; const bfraw* ba = ldsA + ((buf) * BM + wm * TM * 16 + r16) * LDSK; \
    _Pragma("unroll") for (int ks = 0; ks < 2; ++ks) { bf16x8 fw[TN], fa[TM]; const int sw = ((ks * 4 + q4) ^ (r16 >> 1)) * 8; \
      _Pragma("unroll") for (int i = 0; i < TN; ++i) fw[i] = *(const bf16x8*)(bw + i * 16 * LDSK + sw); \
      _Pragma("unroll") for (int j = 0; j < TM; ++j) fa[j] = *(const bf16x8*)(ba + j * 16 * LDSK + sw); \
      _Pragma("unroll") for (int i = 0; i < TN; ++i) _Pragma("unroll") for (int j = 0; j < TM; ++j) acc[i][j] = mfma16(fw[i], fa[j], acc[i][j]); } } while (0)
  static_assert(KT == 2 || KT == 4, "KT is 2 or 4");
  SK_LOAD0(0); SK_LOAD1(1);
  __syncthreads();
  SK_STAGE0(0);
  if constexpr (KT == 4) SK_LOAD0(2);
  __syncthreads();
  SK_STAGE1(1); SK_COMPUTE(0);
  if constexpr (KT == 4) SK_LOAD1(3);
  __syncthreads();
  if constexpr (KT == 4) {
    SK_STAGE0(0); SK_COMPUTE(1);
    __syncthreads();
    SK_STAGE1(1); SK_COMPUTE(0);
    __syncthreads();
  }
  SK_COMPUTE(1);
#undef SK_LOAD0
#undef SK_LOAD1
#undef SK_STAGE0
#undef SK_STAGE1
#undef SK_COMPUTE
}

__device__ __forceinline__ void head_norm64(f32x4 (&acc)[4][4], const float* __restrict__ g, float post, int q4) {
  f32x4 gv[4];
#pragma unroll
  for (int tn = 0; tn < 4; ++tn) gv[tn] = *(const f32x4*)(g + tn * 16 + q4 * 4);
#pragma unroll
  for (int tm = 0; tm < 4; ++tm) {
    float ss = 0.f;
#pragma unroll
    for (int tn = 0; tn < 4; ++tn)
#pragma unroll
      for (int r = 0; r < 4; ++r) ss += acc[tn][tm][r] * acc[tn][tm][r];
    ss = quad_sum(ss);
    const float rs = rsqrtf(ss * (1.f / 64.f) + EPSF) * post;
#pragma unroll
    for (int tn = 0; tn < 4; ++tn)
#pragma unroll
      for (int r = 0; r < 4; ++r) acc[tn][tm][r] *= rs * gv[tn][r];
    __builtin_amdgcn_sched_barrier(0);
  }
}
__device__ __forceinline__ void rope64(f32x4 (&acc)[4][4], const float* __restrict__ cosH, const float* __restrict__ sinH, int mw, int r16, int q4) {
#pragma unroll
  for (int tm = 0; tm < 4; ++tm) {
    const int pos = (mw + tm * 16 + r16 - T_CTX) & 1023;
#pragma unroll
    for (int tn = 0; tn < 2; ++tn) {
      const f32x4 c = *(const f32x4*)(cosH + pos * 32 + tn * 16 + q4 * 4);
      const f32x4 s = *(const f32x4*)(sinH + pos * 32 + tn * 16 + q4 * 4);
#pragma unroll
      for (int r = 0; r < 4; ++r) {
        const float x1 = acc[tn][tm][r], x2 = acc[tn + 2][tm][r];
        acc[tn][tm][r] = x1 * c[r] - x2 * s[r];
        acc[tn + 2][tm][r] = x1 * s[r] + x2 * c[r];
      }
    }
    __builtin_amdgcn_sched_barrier(0);
  }
}
__device__ __forceinline__ void store_rows_bf16(const f32x4 (&acc)[4][4], bfraw* __restrict__ dst, int ld, int col0, int mw, int r16, int q4) {
#pragma unroll
  for (int tm = 0; tm < 4; ++tm) {
    bfraw* p = dst + (size_t)(mw + tm * 16 + r16) * ld + col0 + q4 * 4;
#pragma unroll
    for (int tn = 0; tn < 4; ++tn) *(uint2*)(p + tn * 16) = pack4(acc[tn][tm]);
    __builtin_amdgcn_sched_barrier(0);
  }
}
__device__ __forceinline__ void store_vt(const f32x4 (&acc)[4][4], bfraw* __restrict__ vt, int row0, int mw, int r16, int q4) {
#pragma unroll
  for (int tm = 0; tm < 4; ++tm)
#pragma unroll
    for (int tn = 0; tn < 4; ++tn)
#pragma unroll
      for (int r = 0; r < 4; ++r) vt[(size_t)(row0 + tn * 16 + q4 * 4 + r) * TP + mw + tm * 16 + r16] = f2bf(acc[tn][tm][r]);
}
__device__ __forceinline__ void store_cache_f32(const f32x4 (&acc)[4][4], float* __restrict__ o, int nh, int hh, int mw, int r16, int q4) {
#pragma unroll
  for (int tm = 0; tm < 4; ++tm) {
    const int tok = mw + tm * 16 + r16;
    const int b = tok >> 8, s = tok & 255;
    float* p = o + ((size_t)(b * nh + hh) * 256 + s) * 64 + q4 * 4;
#pragma unroll
    for (int tn = 0; tn < 4; ++tn) *(f32x4*)(p + tn * 16) = acc[tn][tm];
    __builtin_amdgcn_sched_barrier(0);
  }
}

__device__ __forceinline__ int in0_src_col(int l) {
  if (l < 512) return 928 + l;
  if (l < 1024) return 1440 + (l - 512);
  if (l < 1536) return 1952 + (l - 1024);
  if (l < 2048) return 416 + (l - 1536);
  if (l < 2560) return 2464 + (l - 2048);
  if (l < 2816) return l - 2560;
  if (l < 2944) return 256 + (l - 2816);
  if (l < 2976) return 384 + (l - 2944);
  return -1;
}
__device__ __forceinline__ void transpose_item(const float* __restrict__ src, int ld_src, int srccol0, int ncols_valid, bfraw* __restrict__ dst, int K, int nd0, int k0,
                               const float* __restrict__ kscale, float* tile  , int perm_unit = -1, int mode = 0) {
  const int tid = phase_tid();
  const int tx = tid & 63, ty = tid >> 6;
  if (perm_unit >= 0) {
    const int k = (nd0 >> 6) & 3;
    const int l = perm_unit * 256 + (((k & 1) * 2 + (tx >> 5)) * 64) + (k >> 1) * 32 + (tx & 31);
    const int sc = mode ? in0_src_col(l) : l;
    srccol0 = sc - tx;
    ncols_valid = (sc >= 0) ? 64 : 0;
  }
  float v[2][8];
#pragma unroll
  for (int h = 0; h < 2; ++h)
#pragma unroll
    for (int i = 0; i < 8; ++i) {
      const int kk = k0 + h * 64 + ty * 8 + i;
      float x = 0.f;
      if (tx < ncols_valid) {
        x = __builtin_nontemporal_load(src + (size_t)kk * ld_src + srccol0 + tx);
        if (kscale) x *= kscale[kk];
      }
      v[h][i] = x;
    }
#pragma unroll
  for (int h = 0; h < 2; ++h) {
    __syncthreads();
#pragma unroll
    for (int i = 0; i < 8; ++i) tile[(ty * 8 + i) * 65 + tx] = v[h][i];
    __syncthreads();
    const int nl = tid >> 3, kc = tid & 7;
    uint4 u;
    u.x = pack2(tile[(kc * 8 + 0) * 65 + nl], tile[(kc * 8 + 1) * 65 + nl]);
    u.y = pack2(tile[(kc * 8 + 2) * 65 + nl], tile[(kc * 8 + 3) * 65 + nl]);
    u.z = pack2(tile[(kc * 8 + 4) * 65 + nl], tile[(kc * 8 + 5) * 65 + nl]);
    u.w = pack2(tile[(kc * 8 + 6) * 65 + nl], tile[(kc * 8 + 7) * 65 + nl]);
    *(uint4*)(dst + (size_t)(nd0 + nl) * K + k0 + h * 64 + kc * 8) = u;
  }
}

__device__ __forceinline__ void mod_item(const Params& p, int l, int col0, float* ldsf) {
  const int tid = phase_tid();
  float* sc = ldsf;
  float* red = ldsf + 3072;
  __syncthreads();
  for (int i = tid; i < 3072; i += NT) {
    const int cnd = i >> 10, k = i & 1023;
    const float v = (cnd == 0) ? p.in[I_CCTX][k] : p.in[I_C][(cnd - 1) * 1024 + k];
    sc[i] = silu_f(v);
  }
  __syncthreads();
  const int cg8 = tid & 7, kl = tid >> 3;
  float a[3][4];
#pragma unroll
  for (int c = 0; c < 3; ++c)
#pragma unroll
    for (int j = 0; j < 4; ++j) a[c][j] = 0.f;
  const float* wm = p.in[I_WMOD] + (size_t)l * 1024 * 3072 + col0 + cg8 * 4;
#pragma unroll
  for (int i = 0; i < 16; ++i) {
    const int k = kl + 64 * i;
    const f32x4 w = ld_nt4(wm + (size_t)k * 3072);
#pragma unroll
    for (int c = 0; c < 3; ++c) {
      const float s = sc[c * 1024 + k];
#pragma unroll
      for (int j = 0; j < 4; ++j) a[c][j] += s * w[j];
    }
  }
#pragma unroll
  for (int c = 0; c < 3; ++c)
#pragma unroll
    for (int j = 0; j < 4; ++j) red[(kl * 8 + cg8) * 12 + c * 4 + j] = a[c][j];
  __syncthreads();
  if (tid < 96) {
    const int cnd = tid >> 5, col = tid & 31;
    float s = p.in[I_BMOD][l * 3072 + col0 + col];
    for (int k2 = 0; k2 < 64; ++k2) s += red[(k2 * 8 + (col >> 2)) * 12 + cnd * 4 + (col & 3)];
    ((float*)(p.ws + WS_MODF))[(l * 3 + cnd) * 3072 + col0 + col] = s;
  }
}

__device__ __forceinline__ void phase_prep0(const Params& p, unsigned char* ldsraw) {
  float* ldsf = (float*)ldsraw;
  const int tid = phase_tid();
  constexpr int N_MOD = 96, N_WIN0 = 384, N_WIN1 = 0, N_WOUT = 128, N_QUP = 24, N_KVUP = 32, N_ROPE = 0, N_CACHE = 0;
  constexpr int E_MOD = N_MOD, E_WIN0 = E_MOD + N_WIN0, E_WIN1 = E_WIN0 + N_WIN1, E_WOUT = E_WIN1 + N_WOUT, E_QUP = E_WOUT + N_QUP,
                E_KVUP = E_QUP + N_KVUP, E_ROPE = E_KVUP + N_ROPE, E_CACHE = E_ROPE + N_CACHE;
  bfraw* AX = (bfraw*)(p.ws + WS_AX);
  bfraw* VT = (bfraw*)(p.ws + WS_VT);
  for (int it = blockIdx.x; it < E_CACHE; it += gridDim.x) {
    if (it < E_MOD) {
      mod_item(p, 0, it * 32, ldsf);
    } else if (it < E_WIN0) {
      const int j = it - E_MOD;
      const int nt = j % 48, kt = j / 48;
      const int nd0 = nt * 64;
      transpose_item(p.in[I_WINE], 2976, 0, 64, (bfraw*)(p.ws + WS_WIN0), 1024, nd0, kt * 128, nullptr, ldsf, nd0 >> 8, 1);
    } else if (it < E_WOUT) {
      const int j = it - E_WIN1;
      const int nt = j % 16, kt = j / 16;
      transpose_item(p.in[I_WOUTE], 1024, nt * 64, 64, (bfraw*)(p.ws + WS_WOUT0), 1024, nt * 64, kt * 128, nullptr, ldsf);
    } else if (it < E_QUP) {
      const int j = it - E_WOUT;
      const int nt = j % 12, kt = j / 12;
      transpose_item(p.in[I_WQUP], 768, nt * 64, 64, (bfraw*)(p.ws + WS_WQUP), 256, nt * 64, kt * 128, p.in[I_QAG], ldsf);
    } else if (it < E_KVUP) {
      const int j = it - E_QUP;
      const int nt = j % 16, second = j / 16;
      transpose_item(p.in[I_WKVUP], 1024, nt * 64, 64, (bfraw*)(p.ws + (second ? WS_WKVUP2 : WS_WKVUP)), 128, nt * 64, 0, second ? nullptr : p.in[I_KVAG], ldsf);
    }
  }
  {
    const size_t NLP = 8388608 / 16, NLS = 2097152 / 16;
    float sink_v = 0.f;
    for (size_t i = (size_t)blockIdx.x * NT + tid; i < NLP + NLS; i += (size_t)gridDim.x * NT)
      sink_v += (i < NLP) ? p.in[I_XP][i * 16] : p.in[I_XS][(i - NLP) * 16];
    asm volatile("" :: "v"(sink_v));
  }
}

__device__ __forceinline__ void kmax_item(const Params& p, int j, float* red  ) {
  const int tid = phase_tid(), lane = tid & 63, wave = tid >> 6;
  float* km = (float*)(p.ws + WS_KMAX);
  float v = 0.f;
  int slot = 0;
  if (j < 24) {
    const float* src; int grp;
    if (j < 16) { src = p.in[I_CNAK]; grp = j; slot = 8 + j; }
    else if (j < 20) { src = p.in[I_CGQK]; grp = j - 16; slot = 24 + (j - 16); }
    else { src = p.in[I_CSWK]; grp = j - 20; slot = 28 + (j - 20); }
    const int key = tid >> 1, half = tid & 1;
    const float* kp = src + ((size_t)grp * 256 + key) * 64 + half * 32;
    float ss = 0.f;
#pragma unroll
    for (int i = 0; i < 8; ++i) { const f32x4 x = *(const f32x4*)(kp + i * 4); ss += x[0] * x[0] + x[1] * x[1] + x[2] * x[2] + x[3] * x[3]; }
    ss += __shfl_xor(ss, 1);
    v = ss;
  }
  for (int rep = 0; rep < (j < 24 ? 1 : 5); ++rep) {
    if (j >= 24) {
      v = 0.f;
      if (rep == 0) { if (tid < 64) v = fabsf(p.in[I_NAKG][tid]); slot = 0; }
      else if (rep == 1) { if (tid < 96) v = fabsf(p.in[I_MKG][tid]); slot = 1; }
      else if (rep == 2) { if (tid < 64) v = fabsf(p.in[I_GKG][tid]); slot = 2; }
      else if (rep == 3) { if (tid < 64) v = fabsf(p.in[I_SKG][tid]); slot = 3; }
      else { for (int i = tid; i < 8 * 15 * 31; i += NT) v = fmaxf(v, fabsf(p.in[I_RPB][i])); slot = 4; }
    }
#pragma unroll
    for (int o = 1; o < 64; o <<= 1) v = fmaxf(v, __shfl_xor(v, o));
    __syncthreads();
    if (lane == 0) red[wave] = v;
    __syncthreads();
    if (tid == 0) {
      float m = red[0];
      for (int w = 1; w < 8; ++w) m = fmaxf(m, red[w]);
      float out;
      if (j < 24) out = sqrtf(m) * 1.01f;
      else if (rep == 1) out = 9.797958971f * m * 1.01f;
      else if (rep == 4) out = m;
      else out = 8.f * m * 1.01f;
      km[slot] = out;
    }
  }
}

__device__ __forceinline__ void prep_misc_item(const Params& p, int jm, float* ldsf) {
  if (jm >= 196) { kmax_item(p, jm - 196, ldsf + 4096); return; }
  const int tid = phase_tid();
  bfraw* AX = (bfraw*)(p.ws + WS_AX);
  bfraw* VT = (bfraw*)(p.ws + WS_VT);
  if (jm < 48) {
    const int j = jm;
      float* cosA = (float*)(p.ws + WS_COSA); float* sinA = (float*)(p.ws + WS_SINA);
      float* cosH = (float*)(p.ws + WS_COSH); float* sinH = (float*)(p.ws + WS_SINH);
      for (int e = j * 1024 + tid; e < (j + 1) * 1024; e += NT) {
        if (e < 16384) {
          const int pos = e >> 4, i = e & 15;
          const float inv = powf(10000.f, -(float)(i & 7) / 8.f);
          const float ang = (float)((i < 8) ? (pos >> 6) : (pos & 63)) * inv;
          cosA[e] = cosf(ang); sinA[e] = sinf(ang);
        } else {
          const int e2 = e - 16384;
          const int pos = e2 >> 5, i = e2 & 31;
          const float inv = powf(10000.f, -(float)(i & 15) / 16.f);
          const float ang = (float)((i < 16) ? (pos >> 6) : (pos & 63)) * inv;
          cosH[e2] = cosf(ang); sinH[e2] = sinf(ang);
        }
      }
  } else {
    const int j = jm - 48;
      for (int q = 0; q < 8; ++q) {
        if (j < 16) {
          const int e = j * 4096 + q * NT + tid;
          const int b = e >> 15, s = (e >> 7) & 255, d = e & 127;
          AX[(size_t)(T_ALL + b * 256 + s) * LD0 + C0_CKV + d] = f2bf(p.in[I_CCKV][e]);
        } else if (j < 20) {
          const int e = (j - 16) * 4096 + q * NT + tid;
          const int b = e >> 13, s = (e >> 5) & 255, d = e & 31;
          ((float*)(p.ws + WS_KROPE))[(size_t)(T_ALL + b * 256 + s) * 32 + d] = p.in[I_CKROPE][e];
        } else if (j < 84) {
          const int e = (j - 20) * 4096 + q * NT + tid;
          const int b = e >> 17, h = (e >> 14) & 7, s = (e >> 6) & 255, d = e & 63;
          ((bfraw*)(p.ws + WS_KH))[((size_t)h * TP + T_ALL + b * 256 + s) * 64 + d] = f2bf(p.in[I_CNAK][e]);
        } else {
          const int e = (j - 84) * 4096 + q * NT + tid;
          const int b = e >> 17, h = (e >> 14) & 7, s = (e >> 6) & 255, d = e & 63;
          VT[vc_off(h, T_ALL + b * 256 + s, d)] = f2bf(p.in[I_CNAV][e]);
        }
      }
  }
}

__device__ __forceinline__ void prep1_item(const Params& p, int j);
__device__ __forceinline__ void prep_deferred(const Params& p, float* ldsf) {
  constexpr int NUNITS = 160, NITEMS = 448 + 64 + 96;
  const int G = (int)gridDim.x;
  int first, stride;
  if (G > NUNITS) { if ((int)blockIdx.x < NUNITS) return; first = (int)blockIdx.x - NUNITS; stride = G - NUNITS; }
  else { first = (int)blockIdx.x; stride = G; }
  for (int j = first; j < NITEMS; j += stride) {
    if (j < 320) {
      const int nt = j % 40, kt = j / 40;
      transpose_item(p.in[I_WINO], 2560, 0, 64, (bfraw*)(p.ws + WS_WIN1), 1024, nt * 64, kt * 128, nullptr, ldsf, (nt * 64) >> 8, 0);
    } else if (j < 448) {
      const int j2 = j - 320;
      const int nt = j2 % 16, kt = j2 / 16;
      transpose_item(p.in[I_WOUTO], 1024, nt * 64, 64, (bfraw*)(p.ws + WS_WOUT1), 1024, nt * 64, kt * 128, nullptr, ldsf);
    } else {
      if (j < 512) prep1_item(p, j - 448);
      else mod_item(p, 1, (j - 512) * 32, ldsf);
    }
  }
}

__device__ __forceinline__ void prep1_item(const Params& p, int j) {
  bfraw* AX = (bfraw*)(p.ws + WS_AX);
  bfraw* VT = (bfraw*)(p.ws + WS_VT);
  const int tid = phase_tid();
  const int which = j >> 4;
  for (int q = 0; q < 8; ++q) {
    const int e = (j & 15) * 4096 + q * NT + tid;
    const int b = e >> 15, kv = (e >> 14) & 1, s = (e >> 6) & 255, d = e & 63;
    const size_t tok = T_ALL + b * 256 + s;
    if (which == 0) ((bfraw*)(p.ws + WS_KH))[((size_t)kv * TP + tok) * 64 + d] = f2bf(p.in[I_CGQK][e]);
    else if (which == 1) VT[vc_off(kv, (int)tok, d)] = f2bf(p.in[I_CGQV][e]);
    else if (which == 2) ((bfraw*)(p.ws + WS_KH))[((size_t)(2 + kv) * TP + tok) * 64 + d] = f2bf(p.in[I_CSWK][e]);
    else VT[vc_off(2 + kv, (int)tok, d)] = f2bf(p.in[I_CSWV][e]);
  }
}

__device__ __forceinline__ void phase_modulate(const Params& p, int layer, unsigned char* ldsraw) {
  float* gm = (float*)ldsraw;
  float* sh = gm + 1024;
  const int tid = phase_tid(), lane = tid & 63, wave = tid >> 6;
  bfraw* H = (bfraw*)(p.ws + WS_HY);
  const bfraw* X1 = (const bfraw*)(p.ws + WS_X1);
  const int nitems = T_ALL / 32 + (layer == 0 ? 196 + 25 : 0);
  for (int it = blockIdx.x; it < nitems; it += gridDim.x) {
    if (it >= T_ALL / 32) { prep_misc_item(p, it - T_ALL / 32, (float*)ldsraw); continue; }
    const int tok0 = it * 32;
    const int cnd = (tok0 < T_CTX) ? 0 : 1 + ((tok0 - T_CTX) >> 10);
    const float* mf = (const float*)(p.ws + WS_MODF) + (layer * 3 + cnd) * 3072;
    __syncthreads();
    for (int i = tid; i < 1024; i += NT) {
      gm[i] = p.in[I_NORMG][layer * 1024 + i] * (1.f + mf[1024 + i]);
      sh[i] = mf[i];
    }
    __syncthreads();
    f32x4 v[4][4];
#pragma unroll
    for (int rr = 0; rr < 4; ++rr) {
      const int tok = tok0 + wave * 4 + rr;
      if (layer == 0) {
        const float* xr = (tok < T_CTX) ? p.in[I_XP] + (size_t)tok * 1024 : p.in[I_XS] + (size_t)(tok - T_CTX) * 1024;
#pragma unroll
        for (int i = 0; i < 4; ++i) v[rr][i] = *(const f32x4*)(xr + i * 256 + lane * 4);
      } else {
#pragma unroll
        for (int i = 0; i < 4; ++i) v[rr][i] = ld_bf16x4(X1 + (size_t)tok * 1024 + i * 256 + lane * 4);
      }
    }
#pragma unroll
    for (int rr = 0; rr < 4; ++rr) {
      const int tok = tok0 + wave * 4 + rr;
      float ss = 0.f;
#pragma unroll
      for (int i = 0; i < 4; ++i)
#pragma unroll
        for (int r = 0; r < 4; ++r) ss += v[rr][i][r] * v[rr][i][r];
#pragma unroll
      for (int o = 1; o < 64; o <<= 1) ss += __shfl_xor(ss, o);
      const float rs = rsqrtf(ss * (1.f / 1024.f) + EPSF);
#pragma unroll
      for (int i = 0; i < 4; ++i) {
        const int c = i * 256 + lane * 4;
        f32x4 o;
#pragma unroll
        for (int r = 0; r < 4; ++r) o[r] = v[rr][i][r] * rs * gm[c + r] + sh[c + r];
        *(uint2*)(H + (size_t)tok * 1024 + c) = pack4(o);
      }
    }
  }
}

namespace pg8 {
#define PG8_LAS __attribute__((address_space(3)))
constexpr int BM = 256, BK = 64, HALF = 128, HTB = HALF * BK * 2, STAGE_BYTES = 8 * HTB, NXCD = 8, WGM = 8;
__device__ __forceinline__ int lds_byte(int r, int c) { const int st = (r >> 4) * 2 + (c >> 5), rr = r & 15, cc = c & 31, ob = rr * 64 + cc * 2; return st * 1024 + (ob ^ (((ob >> 9) & 1) << 5)); }
__device__ __forceinline__ void stage_rc(int b, int& R, int& C) { const int st = b / 1024, sb = b % 1024, swz = sb ^ (((sb >> 9) & 1) << 5); R = (st >> 1) * 16 + swz / 64; C = (st & 1) * 32 + (swz % 64) / 2; }
struct Unit { int pm, pn; };
struct Gemm { const bfraw* A; const bfraw* Bt; int M, N, K; };
struct StaticOrder {
  int nM, nN, nwg, G, c;
  __device__ void init(int M, int N, int G_, int c_) { nM = M / BM; nN = N / BM; nwg = nM * nN; G = G_; c = c_; }
  __device__ bool next(int i, Unit& u) const {
    const long L = (long)i * G + c; if (L >= nwg) return false;
    int wgid = (int)L; { const int q = nwg / NXCD, r = nwg % NXCD, xcd = wgid % NXCD, off = wgid / NXCD; wgid = (xcd < r ? xcd * (q + 1) : r * (q + 1) + (xcd - r) * q) + off; }
    const int nig = WGM * nN, gid = wgid / nig, fm = gid * WGM, gsz = (nM - fm) < WGM ? (nM - fm) : WGM;
    u.pm = fm + ((wgid % nig) % gsz); u.pn = (wgid % nig) / gsz; return true;
  }
};
template <class Epi>
__device__ __forceinline__ void gemm_phase(PG8_LAS unsigned char* lds, const Gemm g, const StaticOrder& S, const Epi& E) {
  const int tid = phase_tid(), wid = __builtin_amdgcn_readfirstlane(tid >> 6), lane = tid & 63, wr = wid >> 2, wc = wid & 3, fr = lane & 15, fq = lane >> 4;
  const int K = g.K, nt = K / BK;
  unsigned voffA;
  { int R, C; stage_rc(tid * 16, R, C); voffA = (unsigned)(R * K + C) * 2u; }
  const size_t rstep64 = (size_t)64 * K * 2;
  const size_t kstep = (size_t)(BK * 2);
  const size_t hstep = (size_t)HALF * K * 2;
  const size_t tstep = 2 * hstep;
  const unsigned ldsw = (unsigned)wid * 1024u;
  const int aoff = lds_byte(wr * 64 + fr, fq * 8), boff = lds_byte(wc * 32 + fr, fq * 8);
#define PG8_SA(b, h) (((b) * 2 + (h)) * HTB)
#define PG8_SB(b, h) ((4 + (b) * 2 + (h)) * HTB)
#define PG8_STAGE(bufoff, gbase, voff) do { _Pragma("unroll") for (int _i = 0; _i < 2; ++_i) \
    __builtin_amdgcn_global_load_lds((const unsigned*)((const char*)(gbase) + _i * rstep64 + (voff)), (PG8_LAS unsigned*)(lds + (bufoff) + ldsw + _i * 8192), 16, 0, 0); } while (0)
#define PG8_LDA(dst, b, h) do { _Pragma("unroll") for (int m = 0; m < 4; ++m) _Pragma("unroll") for (int k = 0; k < 2; ++k) dst[m][k] = *(const PG8_LAS bf16x8*)(lds + PG8_SA(b, h) + aoff + m * 2048 + k * 1024); } while (0)
#define PG8_LDB(dst, b, h) do { _Pragma("unroll") for (int n = 0; n < 2; ++n) _Pragma("unroll") for (int k = 0; k < 2; ++k) dst[n][k] = *(const PG8_LAS bf16x8*)(lds + PG8_SB(b, h) + boff + n * 2048 + k * 1024); } while (0)
#define PG8_MMA(ai, bj, At, Bt) do { __builtin_amdgcn_s_setprio(1); _Pragma("unroll") for (int m = 0; m < 4; ++m) _Pragma("unroll") for (int n = 0; n < 2; ++n) _Pragma("unroll") for (int k = 0; k < 2; ++k) \
    acc[ai][bj][m][n] = __builtin_amdgcn_mfma_f32_16x16x32_bf16(Bt[n][k], At[m][k], acc[ai][bj][m][n], 0, 0, 0); __builtin_amdgcn_s_setprio(0); } while (0)
#define PG8_WAIT_V(n) asm volatile("s_waitcnt vmcnt(" #n ")" ::: "memory")
#define PG8_WAIT_L(n) asm volatile("s_waitcnt lgkmcnt(" #n ")" ::: "memory")
#define PG8_BAR __builtin_amdgcn_s_barrier()
#define PG8_SCHED __builtin_amdgcn_sched_barrier(0)
  Unit cur, nxt; int ui = 0;
  if (!S.next(0, cur)) return;
  f32x4 acc[2][2][4][2];
#pragma unroll
  for (int a = 0; a < 2; ++a)
#pragma unroll
    for (int b = 0; b < 2; ++b)
#pragma unroll
      for (int m = 0; m < 4; ++m)
#pragma unroll
        for (int n = 0; n < 2; ++n) acc[a][b][m][n] = (f32x4){0.f, 0.f, 0.f, 0.f};
  bf16x8 At[4][2], B0[2][2], B1[2][2];
  const char* cA = (const char*)g.A + (size_t)cur.pm * tstep; const char* cB = (const char*)g.Bt + (size_t)cur.pn * tstep;
  PG8_STAGE(PG8_SB(0, 0), cB, voffA); PG8_STAGE(PG8_SA(0, 0), cA, voffA); PG8_STAGE(PG8_SB(0, 1), cB + hstep, voffA); PG8_STAGE(PG8_SA(0, 1), cA + hstep, voffA);
  if (wr == 1) PG8_BAR;
  PG8_WAIT_V(4); PG8_BAR;
  PG8_STAGE(PG8_SB(1, 0), cB + kstep, voffA); PG8_STAGE(PG8_SA(1, 0), cA + kstep, voffA); PG8_STAGE(PG8_SB(1, 1), cB + hstep + kstep, voffA);
  PG8_WAIT_V(6); PG8_BAR;
  for (;;) {
    const bool has_next = S.next(ui + 1, nxt);
    const char* nA = has_next ? (const char*)g.A + (size_t)nxt.pm * tstep : cA; const char* nB = has_next ? (const char*)g.Bt + (size_t)nxt.pn * tstep : cB;
    for (int t = 0; t < nt; t += 2) {
      const bool last = (t == nt - 2);
      const char* a1 = cA + (size_t)(t + 1) * kstep;
      const char* a2 = last ? nA : cA + (size_t)(t + 2) * kstep; const char* b2 = last ? nB : cB + (size_t)(t + 2) * kstep;
      const char* a3 = a2 + kstep; const char* b3 = b2 + kstep;
      PG8_LDB(B0, 0, 0); PG8_SCHED; PG8_LDA(At, 0, 0); PG8_STAGE(PG8_SA(1, 1), a1 + hstep, voffA);
      PG8_WAIT_L(8); PG8_BAR; PG8_WAIT_L(0); PG8_MMA(0, 0, At, B0); PG8_BAR; PG8_SCHED;
      PG8_LDB(B1, 0, 1); PG8_STAGE(PG8_SB(0, 0), b2, voffA);
      PG8_BAR; PG8_WAIT_L(0); PG8_MMA(0, 1, At, B1); PG8_BAR;
      PG8_LDA(At, 0, 1); PG8_STAGE(PG8_SA(0, 0), a2, voffA);
      PG8_BAR; PG8_WAIT_L(0); PG8_MMA(1, 0, At, B0); PG8_BAR; PG8_SCHED;
      PG8_STAGE(PG8_SB(0, 1), b2 + hstep, voffA);
      PG8_WAIT_V(6); PG8_BAR; PG8_MMA(1, 1, At, B1); PG8_BAR;
      PG8_LDB(B0, 1, 0); PG8_SCHED; PG8_LDA(At, 1, 0); PG8_STAGE(PG8_SA(0, 1), a2 + hstep, voffA);
      PG8_WAIT_L(8); PG8_BAR; PG8_WAIT_L(0); PG8_MMA(0, 0, At, B0); PG8_BAR; PG8_SCHED;
      PG8_LDB(B1, 1, 1); PG8_STAGE(PG8_SB(1, 0), b3, voffA);
      PG8_BAR; PG8_WAIT_L(0); PG8_MMA(0, 1, At, B1); PG8_BAR;
      PG8_LDA(At, 1, 1); PG8_STAGE(PG8_SA(1, 0), a3, voffA);
      PG8_BAR; PG8_WAIT_L(0); PG8_MMA(1, 0, At, B0); PG8_BAR; PG8_SCHED;
      PG8_STAGE(PG8_SB(1, 1), b3 + hstep, voffA);
      PG8_WAIT_V(6); PG8_BAR; PG8_MMA(1, 1, At, B1); PG8_BAR;
    }
    E(acc, cur, wr, wc, fr, fq);
    if (!has_next) break;
#pragma unroll
    for (int a = 0; a < 2; ++a)
#pragma unroll
      for (int b = 0; b < 2; ++b)
#pragma unroll
        for (int m = 0; m < 4; ++m)
#pragma unroll
          for (int n = 0; n < 2; ++n) acc[a][b][m][n] = (f32x4){0.f, 0.f, 0.f, 0.f};
    cur = nxt; cA = nA; cB = nB; ++ui;
  }
  PG8_WAIT_V(0);
  if (wr == 0) PG8_BAR;
  PG8_BAR;
#undef PG8_SA
#undef PG8_SB
#undef PG8_STAGE
#undef PG8_LDA
#undef PG8_LDB
#undef PG8_MMA
#undef PG8_WAIT_V
#undef PG8_WAIT_L
#undef PG8_BAR
#undef PG8_SCHED
}
}

typedef f32x4 SubAcc[4][2];
__device__ __forceinline__ float red16(float v) { v += __shfl_xor(v, 1); v += __shfl_xor(v, 2); v += __shfl_xor(v, 4); v += __shfl_xor(v, 8); return v; }
__device__ __forceinline__ void sub_head_norm(SubAcc& a, const float* __restrict__ g, float post, int fr) {
  float gv[4];
#pragma unroll
  for (int m = 0; m < 4; ++m) gv[m] = g[m * 16 + fr];
#pragma unroll
  for (int n = 0; n < 2; ++n) {
    f32x4 ss = a[0][n] * a[0][n] + a[1][n] * a[1][n] + a[2][n] * a[2][n] + a[3][n] * a[3][n];
    f32x4 rs;
#pragma unroll
    for (int j = 0; j < 4; ++j) rs[j] = rsqrtf(red16(ss[j]) * (1.f / 64.f) + EPSF) * post;
#pragma unroll
    for (int m = 0; m < 4; ++m) a[m][n] = a[m][n] * rs * gv[m];
  }
}
__device__ __forceinline__ void sub_rope64(SubAcc& a, const float* __restrict__ cosH, const float* __restrict__ sinH, int tbase, int fr, int fq) {
#pragma unroll
  for (int n = 0; n < 2; ++n) {
#pragma unroll
    for (int j = 0; j < 4; ++j) {
      const unsigned pos = (unsigned)(((tbase + n * 16 + fq * 4 + j - T_CTX) & 1023) * 32 + fr);
#pragma unroll
      for (int m = 0; m < 2; ++m) {
        const float c = cosH[pos + m * 16], s = sinH[pos + m * 16];
        const float x1 = a[m][n][j], x2 = a[m + 2][n][j];
        a[m][n][j] = x1 * c - x2 * s;
        a[m + 2][n][j] = x1 * s + x2 * c;
      }
      __builtin_amdgcn_sched_barrier(0);
    }
  }
}
__device__ __forceinline__ void sub_store_tok(const SubAcc& a, bfraw* __restrict__ dst, int ld, int col0, int tbase, int fr, int fq) {
#pragma unroll
  for (int n = 0; n < 2; ++n) {
#pragma unroll
    for (int j = 0; j < 4; ++j) {
      const unsigned off = (unsigned)((tbase + n * 16 + fq * 4 + j) * ld + col0 + fr);
#pragma unroll
      for (int m = 0; m < 4; ++m) dst[off + m * 16] = f2bf(a[m][n][j]);
      __builtin_amdgcn_sched_barrier(0);
    }
  }
}
__device__ __forceinline__ void sub_store_vt(const SubAcc& a, bfraw* __restrict__ vt, int row0, int tbase, int fr, int fq) {
#pragma unroll
  for (int m = 0; m < 4; ++m)
#pragma unroll
    for (int n = 0; n < 2; ++n) *(uint2*)(vt + (unsigned)((row0 + m * 16 + fr) * TP + tbase + n * 16 + fq * 4)) = pack4(a[m][n]);
}
__device__ __forceinline__ void sub_store_cache(const SubAcc& a, float* __restrict__ o, int nh, int hh, int tbase, int fr, int fq) {
#pragma unroll
  for (int n = 0; n < 2; ++n) {
#pragma unroll
    for (int j = 0; j < 4; ++j) {
      const int tok = tbase + n * 16 + fq * 4 + j;
      const unsigned off = (unsigned)((((tok >> 8) * nh + hh) * 256 + (tok & 255)) * 64 + fr);
#pragma unroll
      for (int m = 0; m < 4; ++m) o[off + m * 16] = a[m][n][j];
      __builtin_amdgcn_sched_barrier(0);
    }
  }
}
__device__ __forceinline__ void sub_silu(SubAcc& a) {
#pragma unroll
  for (int m = 0; m < 4; ++m)
#pragma unroll
    for (int n = 0; n < 2; ++n)
#pragma unroll
      for (int j = 0; j < 4; ++j) a[m][n][j] = silu_f(a[m][n][j]);
}

struct Row4 { f32x4 a[2][2]; };
__device__ __forceinline__ float row_ss(const Row4& r) {
  f32x4 s = r.a[0][0] * r.a[0][0] + r.a[0][1] * r.a[0][1] + r.a[1][0] * r.a[1][0] + r.a[1][1] * r.a[1][1];
  return quad_sum(s[0] + s[1] + s[2] + s[3]);
}
__device__ __forceinline__ void row_norm(Row4& r, const f32x4 (&gv)[2][2], float post) {
  const float rs = rsqrtf(row_ss(r) * (1.f / 64.f) + EPSF) * post;
#pragma unroll
  for (int bj = 0; bj < 2; ++bj)
#pragma unroll
    for (int n = 0; n < 2; ++n) r.a[bj][n] = r.a[bj][n] * rs * gv[bj][n];
}
__device__ __forceinline__ void row_rope(Row4& r, const float* __restrict__ cosH, const float* __restrict__ sinH, int tok, int fq) {
  const int pos = (tok - T_CTX) & 1023;
#pragma unroll
  for (int n = 0; n < 2; ++n) {
    const f32x4 c = *(const f32x4*)(cosH + pos * 32 + n * 16 + fq * 4);
    const f32x4 s = *(const f32x4*)(sinH + pos * 32 + n * 16 + fq * 4);
    const f32x4 x1 = r.a[0][n], x2 = r.a[1][n];
    r.a[0][n] = x1 * c - x2 * s;
    r.a[1][n] = x1 * s + x2 * c;
  }
}
__device__ __forceinline__ void row_store_bf16(const Row4& r, bfraw* __restrict__ p  ) {
#pragma unroll
  for (int bj = 0; bj < 2; ++bj)
#pragma unroll
    for (int n = 0; n < 2; ++n) *(uint2*)(p + bj * 32 + n * 16) = pack4(r.a[bj][n]);
}
__device__ __forceinline__ void row_store_f32(const Row4& r, float* __restrict__ p) {
#pragma unroll
  for (int bj = 0; bj < 2; ++bj)
#pragma unroll
    for (int n = 0; n < 2; ++n) st_nt4(p + bj * 32 + n * 16, r.a[bj][n]);
}
__device__ __forceinline__ void row_store_f32_keep(const Row4& r, float* __restrict__ p) {
#pragma unroll
  for (int bj = 0; bj < 2; ++bj)
#pragma unroll
    for (int n = 0; n < 2; ++n) *(f32x4*)(p + bj * 32 + n * 16) = r.a[bj][n];
}
__device__ __forceinline__ void row_store_vt(const Row4& r, bfraw* __restrict__ vt  ) {
#pragma unroll
  for (int bj = 0; bj < 2; ++bj)
#pragma unroll
    for (int n = 0; n < 2; ++n)
#pragma unroll
      for (int j = 0; j < 4; ++j) vt[(bj * 32 + n * 16 + j) * 64] = f2bf(r.a[bj][n][j]);
}
__device__ __forceinline__ void row_silu(Row4& r) {
#pragma unroll
  for (int bj = 0; bj < 2; ++bj)
#pragma unroll
    for (int n = 0; n < 2; ++n)
#pragma unroll
      for (int j = 0; j < 4; ++j) r.a[bj][n][j] = silu_f(r.a[bj][n][j]);
}
#define ROW_GET(r, acc, ai, m) do { (r).a[0][0] = acc[ai][0][m][0]; (r).a[0][1] = acc[ai][0][m][1]; (r).a[1][0] = acc[ai][1][m][0]; (r).a[1][1] = acc[ai][1][m][1]; } while (0)

struct EpiIn0 {
  const Params* pp;
  __device__ __forceinline__ void operator()(f32x4 (&acc)[2][2][4][2], const pg8::Unit& u, int wr, int wc, int fr, int fq) const {
    const Params& p = *pp;
    bfraw* AX = (bfraw*)(p.ws + WS_AX);
    bfraw* VT = (bfraw*)(p.ws + WS_VT);
    const int fbase = (u.pn * 4 + wc) * 64;
    const int tok_t = u.pm * 256;
    const bool ctx = tok_t < T_CTX;
    f32x4 gv[2][2];
    const float* g = (fbase < C0_KB) ? p.in[I_NAQG] : p.in[I_NAKG];
#pragma unroll
    for (int bj = 0; bj < 2; ++bj)
#pragma unroll
      for (int n = 0; n < 2; ++n) gv[bj][n] = *(const f32x4*)(g + bj * 32 + n * 16 + fq * 4);
#pragma unroll
    for (int ai = 0; ai < 2; ++ai)
#pragma unroll
      for (int m = 0; m < 4; ++m) {
        const int tok = tok_t + ai * 128 + wr * 64 + m * 16 + fr;
        Row4 r; ROW_GET(r, acc, ai, m);
        bfraw* axp = AX + (size_t)tok * LD0 + fbase + fq * 4;
        if (fbase < C0_KB) {
          row_norm(r, gv, 0.125f * LOG2E);
          row_store_bf16(r, axp);
        } else if (fbase < C0_VB) {
          row_norm(r, gv, 1.f);
          row_store_bf16(r, (bfraw*)(p.ws + WS_KH) + ((size_t)((fbase - C0_KB) >> 6) * TP + tok) * 64 + fq * 4);
          if (ctx) row_store_f32(r, p.out + O_NAK + ((size_t)((tok >> 8) * 8 + ((fbase - C0_KB) >> 6)) * 256 + (tok & 255)) * 64 + fq * 4);
        } else if (fbase < C0_GA) {
          row_store_vt(r, VT + vc_off((fbase - C0_VB) >> 6, tok, fq * 4));
          if (ctx) row_store_f32(r, p.out + O_NAV + ((size_t)((tok >> 8) * 8 + ((fbase - C0_VB) >> 6)) * 256 + (tok & 255)) * 64 + fq * 4);
        } else if (fbase < C0_QLAT) {
          row_silu(r);
          row_store_bf16(r, axp);
        } else if (fbase < C0_CKV) {
          const float ss = row_ss(r);
          if (fq == 0) ((float*)(p.ws + WS_QSS))[(size_t)tok * 4 + ((fbase - C0_QLAT) >> 6)] = ss;
          row_store_bf16(r, axp);
        } else if (fbase < C0_KROPE) {
          const float ss = row_ss(r);
          if (fq == 0) ((float*)(p.ws + WS_CKSS))[(size_t)tok * 2 + ((fbase - C0_CKV) >> 6)] = ss;
          row_store_bf16(r, axp);
          if (ctx) row_store_f32_keep(r, p.out + O_CKV + (size_t)tok * 128 + (fbase - C0_CKV) + fq * 4);
        } else if (fbase == C0_KROPE) {
          float* kr = (float*)(p.ws + WS_KROPE) + (size_t)tok * 32 + fq * 4;
          *(f32x4*)(kr) = r.a[0][0]; *(f32x4*)(kr + 16) = r.a[0][1];
          if (ctx) { float* o = p.out + O_KROPE + (size_t)tok * 32 + fq * 4; st_nt4(o, r.a[0][0]); st_nt4(o + 16, r.a[0][1]); }
        }
        __builtin_amdgcn_sched_barrier(0);
      }
  }
};
__device__ __forceinline__ void phase_gemm_in0(const Params& p, unsigned char* ldsraw) {
  pg8::Gemm g{(const bfraw*)(p.ws + WS_HY), (const bfraw*)(p.ws + WS_WIN0), T_ALL, 3072, 1024};
  pg8::StaticOrder S; S.init(T_ALL, 3072, (int)gridDim.x, (int)blockIdx.x);
  EpiIn0 E{&p};
  __syncthreads();
  pg8::gemm_phase((PG8_LAS unsigned char*)ldsraw, g, S, E);
}

struct EpiIn1 {
  const Params* pp;
  __device__ __forceinline__ void operator()(f32x4 (&acc)[2][2][4][2], const pg8::Unit& u, int wr, int wc, int fr, int fq) const {
    const Params& p = *pp;
    bfraw* AX = (bfraw*)(p.ws + WS_AX);
    bfraw* VT = (bfraw*)(p.ws + WS_VT);
    const float* cosH = (const float*)(p.ws + WS_COSH);
    const float* sinH = (const float*)(p.ws + WS_SINH);
    const int fbase = (u.pn * 4 + wc) * 64;
    const int tok_t = u.pm * 256;
    const bool ctx = tok_t < T_CTX;
    const bool isq = fbase < C1_KC || (fbase >= C1_QD && fbase < C1_KD);
    const bool isk = (fbase >= C1_KC && fbase < C1_VC) || (fbase >= C1_KD && fbase < C1_VD);
    const bool isv = (fbase >= C1_VC && fbase < C1_GC) || (fbase >= C1_VD && fbase < C1_GD);
    const bool isC = fbase < C1_QD;
    const float* g = isq ? (isC ? p.in[I_GQG] : p.in[I_SQG]) : (isC ? p.in[I_GKG] : p.in[I_SKG]);
    f32x4 gv[2][2];
#pragma unroll
    for (int bj = 0; bj < 2; ++bj)
#pragma unroll
      for (int n = 0; n < 2; ++n) gv[bj][n] = *(const f32x4*)(g + bj * 32 + n * 16 + fq * 4);
#pragma unroll
    for (int ai = 0; ai < 2; ++ai)
#pragma unroll
      for (int m = 0; m < 4; ++m) {
        const int tok = tok_t + ai * 128 + wr * 64 + m * 16 + fr;
        Row4 r; ROW_GET(r, acc, ai, m);
        bfraw* axp = AX + (size_t)tok * LD1 + fbase + fq * 4;
        if (isq) {
          row_norm(r, gv, 0.125f * LOG2E);
          if (!ctx) row_rope(r, cosH, sinH, tok, fq);
          row_store_bf16(r, axp);
        } else if (isk) {
          row_norm(r, gv, 1.f);
          if (ctx) row_store_f32(r, p.out + (isC ? O_GQK : O_SWK) + ((size_t)((tok >> 8) * 2 + ((fbase - (isC ? C1_KC : C1_KD)) >> 6)) * 256 + (tok & 255)) * 64 + fq * 4);
          else row_rope(r, cosH, sinH, tok, fq);
          row_store_bf16(r, (bfraw*)(p.ws + WS_KH) + ((size_t)(isC ? ((fbase - C1_KC) >> 6) : 2 + ((fbase - C1_KD) >> 6)) * TP + tok) * 64 + fq * 4);
        } else if (isv) {
          const int vh = isC ? ((fbase - C1_VC) >> 6) : 2 + ((fbase - C1_VD) >> 6);
          row_store_vt(r, VT + vc_off(vh, tok, fq * 4));
          if (ctx) row_store_f32(r, p.out + (isC ? O_GQV : O_SWV) + ((size_t)((tok >> 8) * 2 + ((fbase - (isC ? C1_VC : C1_VD)) >> 6)) * 256 + (tok & 255)) * 64 + fq * 4);
        } else {
          row_silu(r);
          row_store_bf16(r, axp);
        }
        __builtin_amdgcn_sched_barrier(0);
      }
  }
};
__device__ __forceinline__ void phase_gemm_in1(const Params& p, unsigned char* ldsraw) {
  pg8::Gemm g{(const bfraw*)(p.ws + WS_HY), (const bfraw*)(p.ws + WS_WIN1), T_ALL, 2560, 1024};
  pg8::StaticOrder S; S.init(T_ALL, 2560, (int)gridDim.x, (int)blockIdx.x);
  EpiIn1 E{&p};
  __syncthreads();
  pg8::gemm_phase((PG8_LAS unsigned char*)ldsraw, g, S, E);
}

struct EpiOut {
  const Params* pp; int layer;
  __device__ __forceinline__ void operator()(f32x4 (&acc)[2][2][4][2], const pg8::Unit& u, int wr, int wc, int fr, int fq) const {
    const Params& p = *pp;
    bfraw* X1 = (bfraw*)(p.ws + WS_X1);
    const int tok_t = u.pm * 256;
    const int cnd = (tok_t < T_CTX) ? 0 : 1 + ((tok_t - T_CTX) >> 10);
    const float* gate = (const float*)(p.ws + WS_MODF) + (layer * 3 + cnd) * 3072 + 2048;
    const int col0 = u.pn * 256 + wc * 32 + fq * 4;
    f32x4 gv[2][2];
#pragma unroll
    for (int bj = 0; bj < 2; ++bj)
#pragma unroll
      for (int n = 0; n < 2; ++n) gv[bj][n] = *(const f32x4*)(gate + col0 + bj * 128 + n * 16);
#pragma unroll
    for (int ai = 0; ai < 2; ++ai)
#pragma unroll
      for (int m = 0; m < 4; ++m) {
        const int tok = tok_t + ai * 128 + wr * 64 + m * 16 + fr;
        const float* xr = (tok < T_CTX) ? p.in[I_XP] + (size_t)tok * 1024 : p.in[I_XS] + (size_t)(tok - T_CTX) * 1024;
        bfraw* x1r = X1 + (size_t)tok * 1024;
        float* orow = p.out + (size_t)tok * 1024;
#pragma unroll
        for (int bj = 0; bj < 2; ++bj)
#pragma unroll
          for (int n = 0; n < 2; ++n) {
            const int c = col0 + bj * 128 + n * 16;
            const f32x4 xv = (layer == 0) ? *(const f32x4*)(xr + c) : ld_bf16x4(x1r + c);
            const f32x4 ov = xv + gv[bj][n] * acc[ai][bj][m][n];
            if (layer == 1) st_nt4(orow + c, ov); else *(uint2*)(x1r + c) = pack4(ov);
          }
        if (m == 3) __builtin_amdgcn_sched_barrier(0);
      }
  }
};
__device__ __forceinline__ void phase_gemm_out(const Params& p, int layer, unsigned char* ldsraw) {
  pg8::Gemm g{(const bfraw*)(p.ws + WS_HY), (const bfraw*)(p.ws + (layer ? WS_WOUT1 : WS_WOUT0)), T_ALL, 1024, 1024};
  pg8::StaticOrder S; S.init(T_ALL, 1024, (int)gridDim.x, (int)blockIdx.x);
  EpiOut E{&p, layer};
  __syncthreads();
  pg8::gemm_phase((PG8_LAS unsigned char*)ldsraw, g, S, E);
  if (layer == 0) prep_deferred(p, (float*)ldsraw);
}

__device__ __forceinline__ void phase_up0(const Params& p, unsigned char* ldsraw) {
  bfraw* lds = (bfraw*)ldsraw;
  const bfraw* AX = (const bfraw*)(p.ws + WS_AX);
  const float* cosA = (const float*)(p.ws + WS_COSA);
  const float* sinA = (const float*)(p.ws + WS_SINA);
  const int tid = phase_tid(), lane = tid & 63, wave = tid >> 6;
  const int r16 = lane & 15, q4 = lane >> 4;
  constexpr int NQ = 40 * 8, NKV = 42 * 8, NFIN = 128;
  for (int tile = blockIdx.x; tile < NQ + NKV + NFIN; tile += gridDim.x) {
    if (tile >= NQ + NKV) {
      const int j = tile - NQ - NKV;
      const float* ckss = (const float*)(p.ws + WS_CKSS);
      const float* kg = p.in[I_KVAG];
#pragma unroll 4
      for (int q = 0; q < 16; ++q) {
        const int e = q * NT + tid;
        const int tok = j * 64 + (e >> 7), d = e & 127;
        const float rs = rsqrtf((ckss[(size_t)tok * 2] + ckss[(size_t)tok * 2 + 1]) * (1.f / 128.f) + EPSF);
        float* o = p.out + O_CKV + (size_t)tok * 128 + d;
        __builtin_nontemporal_store(*o * rs * kg[d], o);
      }
    } else if (tile < NQ) {
      const int h = tile % 8, mt = tile / 8;
      const int m0 = mt * 256;
      f32x4 acc[6][2];
      gemm_smallk<6, 2, 1, 8, 4>((const bfraw*)(p.ws + WS_WQUP), 256, AX + C0_QLAT, LD0, h * 96, m0, lds, acc);
      const int mw = m0 + wave * 32;
      const float* qss = (const float*)(p.ws + WS_QSS);
      const float* qg = p.in[I_MQG];
      bfraw* QA = (bfraw*)(p.ws + WS_QA);
      f32x4 gv[6];
#pragma unroll
      for (int tn = 0; tn < 6; ++tn) gv[tn] = *(const f32x4*)(qg + tn * 16 + q4 * 4);
      const bool lat = m0 >= T_CTX;
#pragma unroll
      for (int tm = 0; tm < 2; ++tm) {
        const int tok = mw + tm * 16 + r16;
        const f32x4 s4 = *(const f32x4*)(qss + (size_t)tok * 4);
        const float rq = rsqrtf((s4[0] + s4[1] + s4[2] + s4[3]) * (1.f / 256.f) + EPSF);
        float ss = 0.f;
#pragma unroll
        for (int tn = 0; tn < 6; ++tn)
#pragma unroll
          for (int r = 0; r < 4; ++r) { acc[tn][tm][r] *= rq; ss += acc[tn][tm][r] * acc[tn][tm][r]; }
        ss = quad_sum(ss);
        const float rs = rsqrtf(ss * (1.f / 96.f) + EPSF);
#pragma unroll
        for (int tn = 0; tn < 6; ++tn)
#pragma unroll
          for (int r = 0; r < 4; ++r) acc[tn][tm][r] *= rs * gv[tn][r];
        if (lat) {
          const int pos = (tok - T_CTX) & 1023;
          const f32x4 c = *(const f32x4*)(cosA + pos * 16 + q4 * 4);
          const f32x4 s = *(const f32x4*)(sinA + pos * 16 + q4 * 4);
#pragma unroll
          for (int r = 0; r < 4; ++r) {
            const float x1 = acc[4][tm][r], x2 = acc[5][tm][r];
            acc[4][tm][r] = x1 * c[r] - x2 * s[r];
            acc[5][tm][r] = x1 * s[r] + x2 * c[r];
          }
        }
        const float sc = 0.10206207261596577f * LOG2E;
        bfraw* o = QA + (size_t)tok * 768 + h * 96 + q4 * 4;
#pragma unroll
        for (int tn = 0; tn < 6; ++tn) {
          f32x4 v = acc[tn][tm];
#pragma unroll
          for (int r = 0; r < 4; ++r) v[r] *= sc;
          *(uint2*)(o + tn * 16) = pack4(v);
        }
      }
    } else {
      const int t2 = tile - NQ;
      const int h = t2 % 8, mt = t2 / 8;
      const int m0 = mt * 256;
      f32x4 acc[4][4];
      const bool fresh = m0 < T_ALL;
      gemm_smallk<4, 4, 2, 4, 2>((const bfraw*)(p.ws + (fresh ? WS_WKVUP : WS_WKVUP2)), 128, AX + C0_CKV, LD0, h * 128, m0, lds, acc);
      const int wn = wave & 1, wm = wave >> 1;
      const int mw = m0 + wm * 64;
      if (fresh) {
        const float* ckss = (const float*)(p.ws + WS_CKSS);
#pragma unroll
        for (int tm = 0; tm < 4; ++tm) {
          const int tok = mw + tm * 16 + r16;
          const float rsc = rsqrtf((ckss[(size_t)tok * 2] + ckss[(size_t)tok * 2 + 1]) * (1.f / 128.f) + EPSF);
#pragma unroll
          for (int tn = 0; tn < 4; ++tn) acc[tn][tm] = acc[tn][tm] * rsc;
        }
      }
      if (wn == 0) {
        const float* kr = (const float*)(p.ws + WS_KROPE);
        const float* kg = p.in[I_MKG];
        bfraw* KA = (bfraw*)(p.ws + WS_KA);
        const bool lat = (m0 >= T_CTX) && (m0 < T_ALL);
        f32x4 gv[4];
#pragma unroll
        for (int tn = 0; tn < 4; ++tn) gv[tn] = *(const f32x4*)(kg + tn * 16 + q4 * 4);
        const f32x4 g1 = *(const f32x4*)(kg + 64 + q4 * 4), g2 = *(const f32x4*)(kg + 80 + q4 * 4);
#pragma unroll
        for (int tm = 0; tm < 4; ++tm) {
          const int tok = mw + tm * 16 + r16;
          f32x4 k1 = *(const f32x4*)(kr + (size_t)tok * 32 + q4 * 4);
          f32x4 k2 = *(const f32x4*)(kr + (size_t)tok * 32 + 16 + q4 * 4);
          float ss = 0.f;
#pragma unroll
          for (int r = 0; r < 4; ++r) ss += k1[r] * k1[r] + k2[r] * k2[r];
#pragma unroll
          for (int tn = 0; tn < 4; ++tn)
#pragma unroll
            for (int r = 0; r < 4; ++r) ss += acc[tn][tm][r] * acc[tn][tm][r];
          ss = quad_sum(ss);
          const float rs = rsqrtf(ss * (1.f / 96.f) + EPSF);
          bfraw* o = KA + ((size_t)h * TP + tok) * 96 + q4 * 4;
#pragma unroll
          for (int tn = 0; tn < 4; ++tn) {
            f32x4 v;
#pragma unroll
            for (int r = 0; r < 4; ++r) v[r] = acc[tn][tm][r] * rs * gv[tn][r];
            *(uint2*)(o + tn * 16) = pack4(v);
          }
#pragma unroll
          for (int r = 0; r < 4; ++r) { k1[r] *= rs * g1[r]; k2[r] *= rs * g2[r]; }
          if (lat) {
            const int pos = (tok - T_CTX) & 1023;
            const f32x4 c = *(const f32x4*)(cosA + pos * 16 + q4 * 4);
            const f32x4 s = *(const f32x4*)(sinA + pos * 16 + q4 * 4);
#pragma unroll
            for (int r = 0; r < 4; ++r) {
              const float x1 = k1[r], x2 = k2[r];
              k1[r] = x1 * c[r] - x2 * s[r];
              k2[r] = x1 * s[r] + x2 * c[r];
            }
          }
          *(uint2*)(o + 64) = pack4(k1);
          *(uint2*)(o + 80) = pack4(k2);
          __builtin_amdgcn_sched_barrier(0);
        }
      } else {
        {
          bfraw* VT = (bfraw*)(p.ws + WS_VT);
#pragma unroll
          for (int tm = 0; tm < 4; ++tm)
#pragma unroll
            for (int tn = 0; tn < 4; ++tn)
#pragma unroll
              for (int r = 0; r < 4; ++r) VT[vc_off(8 + h, mw + tm * 16 + r16, tn * 16 + q4 * 4 + r)] = f2bf(acc[tn][tm][r]);
        }
      }
    }
  }
}

template <int DKS, int QG>
struct AttnState {
  f32x4 o[4][QG];
  float m[QG], l[QG];
  bf16x8 q[QG][DKS];
};

template <int DKS, int QG, int MASK>
__device__ __forceinline__ void attn_chunk(AttnState<DKS, QG>& st, const bfraw* __restrict__ kbase, int ldk, const bfraw* __restrict__ vtbase, int ldv,
                                           int r16, int q4, int qpos0, int kpos0, const float* __restrict__ rpbrow, int qcol0, int kcol0) {
  bf16x8 kf[2][DKS];
#pragma unroll
  for (int kt = 0; kt < 2; ++kt)
#pragma unroll
    for (int ks = 0; ks < DKS; ++ks) kf[kt][ks] = *(const bf16x8*)(kbase + (kt * 16 + r16) * ldk + ks * 32 + q4 * 8);
  bf16x8 vf[4];
#pragma unroll
  for (int dt = 0; dt < 4; ++dt) {
    const bfraw* vp = vtbase + (dt * 16 + r16) * ldv + q4 * 4;
    const uint2 a = *(const uint2*)vp;
    const uint2 b = *(const uint2*)(vp + 16);
    uint4 u; u.x = a.x; u.y = a.y; u.z = b.x; u.w = b.y;
    vf[dt] = __builtin_bit_cast(bf16x8, u);
  }
#pragma unroll
  for (int g = 0; g < QG; ++g) {
    f32x4 s[2];
#pragma unroll
    for (int kt = 0; kt < 2; ++kt) {
      s[kt] = f32x4{0.f, 0.f, 0.f, 0.f};
#pragma unroll
      for (int ks = 0; ks < DKS; ++ks) s[kt] = mfma16(kf[kt][ks], st.q[g][ks], s[kt]);
    }
    if (MASK == 1) {
      const int qp = qpos0 + g * 16 + r16;
#pragma unroll
      for (int kt = 0; kt < 2; ++kt)
#pragma unroll
        for (int r = 0; r < 4; ++r) {
          const int kp = kpos0 + kt * 16 + q4 * 4 + r;
          const int d = qp - kp;
          if (d > 128 || d < -128) s[kt][r] = -1e30f;
        }
    } else if (MASK == 2) {
      const int qc = qcol0 + r16;
      int cs = qc - 8; cs = cs < 0 ? 0 : (cs > 48 ? 48 : cs);
#pragma unroll
      for (int kt = 0; kt < 2; ++kt)
#pragma unroll
        for (int r = 0; r < 4; ++r) {
          const int kc = kcol0 + kt * 16 + q4 * 4 + r;
          int dc = kc - qc + 15; dc = dc < 0 ? 0 : (dc > 30 ? 30 : dc);
          const bool valid = (kc >= cs) && (kc < cs + 16);
          s[kt][r] = valid ? s[kt][r] + rpbrow[dc] * LOG2E : -1e30f;
        }
    }
    const float mref = st.m[g];
    float ps = 0.f;
    f32x4 p0, p1;
#pragma unroll
    for (int r = 0; r < 4; ++r) { p0[r] = __builtin_amdgcn_exp2f(s[0][r] - mref); p1[r] = __builtin_amdgcn_exp2f(s[1][r] - mref); ps += p0[r] + p1[r]; }
    st.l[g] += ps;
    uint4 u;
    u.x = pack2(p0[0], p0[1]); u.y = pack2(p0[2], p0[3]); u.z = pack2(p1[0], p1[1]); u.w = pack2(p1[2], p1[3]);
    const bf16x8 pf = __builtin_bit_cast(bf16x8, u);
#pragma unroll
    for (int dt = 0; dt < 4; ++dt) st.o[dt][g] = mfma16(vf[dt], pf, st.o[dt][g]);
  }
}

template <int DKS, int QG>
__device__ __forceinline__ void attn_init(AttnState<DKS, QG>& st, const bfraw* __restrict__ qbase, int ldq, int r16, int q4, bool has_sink, float sinkv,
                                          float kbound, float bias_bound) {
#pragma unroll
  for (int g = 0; g < QG; ++g) {
#pragma unroll
    for (int ks = 0; ks < DKS; ++ks) st.q[g][ks] = *(const bf16x8*)(qbase + (size_t)(g * 16 + r16) * ldq + ks * 32 + q4 * 8);
#pragma unroll
    for (int dt = 0; dt < 4; ++dt) st.o[dt][g] = f32x4{0.f, 0.f, 0.f, 0.f};
    float qq = 0.f;
#pragma unroll
    for (int ks = 0; ks < DKS; ++ks)
#pragma unroll
      for (int e = 0; e < 8; ++e) { const float x = (float)st.q[g][ks][e]; qq += x * x; }
    qq = quad_sum(qq);
    float mref = sqrtf(qq) * kbound + bias_bound;
    if (has_sink) mref = fmaxf(mref, sinkv * LOG2E);
    st.m[g] = mref;
    st.l[g] = (has_sink && q4 == 0) ? __builtin_amdgcn_exp2f(sinkv * LOG2E - mref) : 0.f;
  }
}

template <int DKS, int QG>
__device__ __forceinline__ void attn_finish(AttnState<DKS, QG>& st, const bfraw* __restrict__ gate, int ldg, bfraw* __restrict__ Y, int tok0, int r16, int q4) {
#pragma unroll
  for (int g = 0; g < QG; ++g) {
    const float l = quad_sum(st.l[g]);
    const float inv = 1.f / l;
    const int tok = tok0 + g * 16 + r16;
#pragma unroll
    for (int dt = 0; dt < 4; ++dt) {
      const uint2 gu = *(const uint2*)(gate + (size_t)tok * ldg + dt * 16 + q4 * 4);
      f32x4 v;
      v[0] = st.o[dt][g][0] * inv * bf2f(gu.x & 0xffffu);
      v[1] = st.o[dt][g][1] * inv * bf2f(gu.x >> 16);
      v[2] = st.o[dt][g][2] * inv * bf2f(gu.y & 0xffffu);
      v[3] = st.o[dt][g][3] * inv * bf2f(gu.y >> 16);
      *(uint2*)(Y + (size_t)tok * 1024 + dt * 16 + q4 * 4) = pack4(v);
    }
  }
}

template <int QG>
__device__ __forceinline__ void gate_load(uint2 (&gu)[QG][4], const bfraw* __restrict__ gate, int ldg, int tok0, int r16, int q4) {
#pragma unroll
  for (int g = 0; g < QG; ++g)
#pragma unroll
    for (int dt = 0; dt < 4; ++dt) gu[g][dt] = *(const uint2*)(gate + (size_t)(tok0 + g * 16 + r16) * ldg + dt * 16 + q4 * 4);
}
template <int DKS, int QG>
__device__ __forceinline__ void attn_finish_g(AttnState<DKS, QG>& st, const uint2 (&gu)[QG][4], bfraw* __restrict__ Y, int tok0, int r16, int q4) {
#pragma unroll
  for (int g = 0; g < QG; ++g) {
    const float inv = 1.f / quad_sum(st.l[g]);
    const int tok = tok0 + g * 16 + r16;
#pragma unroll
    for (int dt = 0; dt < 4; ++dt) {
      f32x4 v;
      v[0] = st.o[dt][g][0] * inv * bf2f(gu[g][dt].x & 0xffffu);
      v[1] = st.o[dt][g][1] * inv * bf2f(gu[g][dt].x >> 16);
      v[2] = st.o[dt][g][2] * inv * bf2f(gu[g][dt].y & 0xffffu);
      v[3] = st.o[dt][g][3] * inv * bf2f(gu[g][dt].y >> 16);
      *(uint2*)(Y + (size_t)tok * 1024 + dt * 16 + q4 * 4) = pack4(v);
    }
  }
}

#define VSTR 72
template <int DKS>
struct KVStage {
  static constexpr int KSTR = DKS * 32 + 16;
  static constexpr int BUF = 64 * KSTR + 64 * VSTR;
  static constexpr int NKC = 64 * DKS * 4;
  static constexpr int NRK = (NKC + NT - 1) / NT;
};
template <int DKS>
__device__ __forceinline__ void kv_gload(uint4& k0, uint4& k1, uint4& v, const bfraw* __restrict__ Kp, int ldk, const bfraw* __restrict__ Vt, int tid) {
  { const int c = tid; const int row = c / (DKS * 4), kc = c % (DKS * 4); k0 = *(const uint4*)(Kp + (size_t)row * ldk + kc * 8); }
  if (KVStage<DKS>::NRK > 1) {
    int c = tid + NT; if (c >= KVStage<DKS>::NKC) c = KVStage<DKS>::NKC - 1;
    const int row = c / (DKS * 4), kc = c % (DKS * 4);
    k1 = *(const uint4*)(Kp + (size_t)row * ldk + kc * 8);
  }
  { const int row = tid >> 3, kc = tid & 7; v = *(const uint4*)(Vt + row * 64 + kc * 8); }
}
template <int DKS>
__device__ __forceinline__ void kv_lstore(const uint4& k0, const uint4& k1, const uint4& v, bfraw* buf, int tid) {
  constexpr int KSTR = KVStage<DKS>::KSTR;
  bfraw* lk = buf; bfraw* lv = buf + 64 * KSTR;
  { const int c = tid; const int row = c / (DKS * 4), kc = c % (DKS * 4); *(uint4*)(lk + row * KSTR + kc * 8) = k0; }
  if (KVStage<DKS>::NRK > 1) {
    const int c = tid + NT;
    if (c < KVStage<DKS>::NKC) { const int row = c / (DKS * 4), kc = c % (DKS * 4); *(uint4*)(lk + row * KSTR + kc * 8) = k1; }
  }
  { const int row = tid >> 3, kc = tid & 7; *(uint4*)(lv + row * VSTR + kc * 8) = v; }
}

template <int DKS, class TokF, class CompF>
__device__ __forceinline__ void kv_pipeline(int N, TokF tokOf, CompF compute, const bfraw* __restrict__ Kp, int ldk, const bfraw* __restrict__ Vt, bfraw* lds, int tid) {
  constexpr int BUF = KVStage<DKS>::BUF;
  uint4 kA0, kA1 = {0u, 0u, 0u, 0u}, vA, kB0, kB1 = {0u, 0u, 0u, 0u}, vB;
  __syncthreads();
  { const int t0 = tokOf(0); kv_gload<DKS>(kA0, kA1, vA, Kp + (size_t)t0 * ldk, ldk, Vt + (size_t)(t0 >> 6) * 4096, tid); }
  kv_lstore<DKS>(kA0, kA1, vA, lds, tid);
  { const int t1 = tokOf(N > 1 ? 1 : 0); kv_gload<DKS>(kA0, kA1, vA, Kp + (size_t)t1 * ldk, ldk, Vt + (size_t)(t1 >> 6) * 4096, tid); }
  __syncthreads();
  for (int c = 0; c < N; c += 2) {
    { const int cn = (c + 2 < N) ? c + 2 : N - 1; const int tk = tokOf(cn); kv_gload<DKS>(kB0, kB1, vB, Kp + (size_t)tk * ldk, ldk, Vt + (size_t)(tk >> 6) * 4096, tid); }
    compute(c, lds, lds + 64 * KVStage<DKS>::KSTR);
    kv_lstore<DKS>(kA0, kA1, vA, lds + BUF, tid);
    __syncthreads();
    { const int cn = (c + 3 < N) ? c + 3 : N - 1; const int tk = tokOf(cn); kv_gload<DKS>(kA0, kA1, vA, Kp + (size_t)tk * ldk, ldk, Vt + (size_t)(tk >> 6) * 4096, tid); }
    if (c + 1 < N) compute(c + 1, lds + BUF, lds + BUF + 64 * KVStage<DKS>::KSTR);
    kv_lstore<DKS>(kB0, kB1, vB, lds, tid);
    __syncthreads();
  }
}

template <int DKS, bool WINDOW, int QG>
__device__ __forceinline__ void attn_block(const bfraw* __restrict__ Q, int ldq, const bfraw* __restrict__ Kp, int ldk, const bfraw* __restrict__ Vt,
                                           const bfraw* __restrict__ gate, int ldg, bfraw* __restrict__ Y,
                                           int qtok0, int s1tok, int n1, int s2tok, int n2, bool has_sink, float sinkv, int qpos_w, int kpos1, bfraw* lds, float kbound) {
  const int tid = phase_tid(), lane = tid & 63, wave = tid >> 6;
  const int r16 = lane & 15, q4 = lane >> 4;
  constexpr int KSTR = KVStage<DKS>::KSTR, BUF = KVStage<DKS>::BUF;
  AttnState<DKS, QG> st;
  const int qtok_w = qtok0 + wave * (16 * QG);
  attn_init<DKS, QG>(st, Q + (size_t)qtok_w * ldq, ldq, r16, q4, has_sink, sinkv, kbound, 0.f);
  uint2 gu[QG][4];
  gate_load<QG>(gu, gate, ldg, qtok_w, r16, q4);
  const int N = n1 + n2;
  kv_pipeline<DKS>(N,
    [&](int c) { return (c < n1) ? s1tok + c * 64 : s2tok + (c - n1) * 64; },
    [&](int c, const bfraw* bk, const bfraw* bv) {
#pragma unroll 1
      for (int sub = 0; sub < 2; ++sub) {
        if (WINDOW && c < n1) {
          const int kp = kpos1 + c * 64 + sub * 32;
          if (!(kp + 31 < qpos_w - 128 || kp > qpos_w + (16 * QG - 1) + 128))
            attn_chunk<DKS, QG, 1>(st, bk + sub * 32 * KSTR, KSTR, bv + sub * 32, VSTR, r16, q4, qpos_w, kp, nullptr, 0, 0);
        } else {
          attn_chunk<DKS, QG, 0>(st, bk + sub * 32 * KSTR, KSTR, bv + sub * 32, VSTR, r16, q4, 0, 0, nullptr, 0, 0);
        }
      }
    }, Kp, ldk, Vt, lds, tid);
  attn_finish_g<DKS, QG>(st, gu, Y, qtok_w, r16, q4);
}

__device__ __forceinline__ void phase_attn0(const Params& p, unsigned char* ldsraw) {
  bfraw* lds = (bfraw*)ldsraw;
  const bfraw* AX = (const bfraw*)(p.ws + WS_AX);
  const bfraw* VT = (const bfraw*)(p.ws + WS_VT);
  const bfraw* QA = (const bfraw*)(p.ws + WS_QA);
  const bfraw* KA = (const bfraw*)(p.ws + WS_KA);
  bfraw* Y = (bfraw*)(p.ws + WS_HY);
  const float* kmax = (const float*)(p.ws + WS_KMAX);
  const int tid = phase_tid(), lane = tid & 63, wave = tid >> 6;
  const int r16 = lane & 15, q4 = lane >> 4;
  if (__builtin_amdgcn_readfirstlane(tid) >= 256) __builtin_amdgcn_s_setprio(1);
  constexpr int N_LA = 128, N_NB = 128, N_CA = 256, N_CB = 256;
  constexpr int E_LA = N_LA, E_NB = E_LA + N_NB, E_CA = E_NB + N_CA, E_CB = E_CA + N_CB;
  for (int it = blockIdx.x; it < E_CB; it += gridDim.x) {
    if (it < E_LA) {
      const int qb = it & 7, h = (it >> 3) & 7, b = it >> 6;
      attn_block<3, false, 1>(QA + h * 96, 768, KA + (size_t)h * TP * 96, 96, VT + (size_t)(8 + h) * VCHUNKS * 4096, AX + C0_GA + h * 64, LD0, Y + h * 64,
                           T_CTX + b * 1024 + qb * 128, T_CTX + b * 1024, 16, T_ALL + b * 256, 4, false, 0.f, 0, 0, lds, kmax[1]);
    } else if (it < E_NB) {
      const int j2 = it - E_LA;
      const int rp = j2 & 7, h = (j2 >> 3) & 7, b = j2 >> 6;
      const int jb = wave & 3, rrow = rp * 2 + (wave >> 2);
      const int qtok0 = T_CTX + b * 1024 + rrow * 64 + jb * 16;
      constexpr int KSTR = KVStage<2>::KSTR, BUF = KVStage<2>::BUF;
      AttnState<2, 1> st;
      attn_init<2, 1>(st, AX + (size_t)qtok0 * LD0 + C0_QB + h * 64, LD0, r16, q4, false, 0.f, fmaxf(kmax[0], kmax[8 + b * 8 + h]), kmax[4] * LOG2E);
      int rs = rrow - 4; rs = rs < 0 ? 0 : (rs > 8 ? 8 : rs);
      int lo = rp * 2 - 4; lo = lo < 0 ? 0 : (lo > 8 ? 8 : lo);
      int hi = rp * 2 + 1 - 4; hi = hi < 0 ? 0 : (hi > 8 ? 8 : hi); hi += 7;
      const int nrows = hi - lo + 1;
      int cst = jb * 16 - 8; cst = cst < 0 ? 0 : (cst > 32 ? 32 : cst);
      const float* rpb = p.in[I_RPB] + h * (15 * 31);
      const bfraw* Kp = (const bfraw*)(p.ws + WS_KH) + (size_t)h * TP * 64;
      const bfraw* Vp = VT + (size_t)h * VCHUNKS * 4096;
      const int lat0 = T_CTX + b * 1024 + lo * 64;
      const int N = nrows + 4;
      kv_pipeline<2>(N,
        [&](int c) { return (c < nrows) ? lat0 + c * 64 : T_ALL + b * 256 + (c - nrows) * 64; },
        [&](int c, const bfraw* bk, const bfraw* bv) {
          if (c < nrows) {
            const int krow = lo + c;
            if (krow >= rs && krow < rs + 8) {
              const int dr = krow - rrow + 7;
              attn_chunk<2, 1, 2>(st, bk + cst * KSTR, KSTR, bv + cst, VSTR, r16, q4, 0, 0, rpb + dr * 31, jb * 16, cst);
            }
          } else {
            attn_chunk<2, 1, 0>(st, bk, KSTR, bv, VSTR, r16, q4, 0, 0, nullptr, 0, 0);
            attn_chunk<2, 1, 0>(st, bk + 32 * KSTR, KSTR, bv + 32, VSTR, r16, q4, 0, 0, nullptr, 0, 0);
          }
        }, Kp, 64, Vp, lds, tid);
      attn_finish<2, 1>(st, AX + C0_GB + h * 64, LD0, Y + 512 + h * 64, qtok0, r16, q4);
    } else if (it < E_CA) {
      const int j2 = it - E_NB;
      const int h = j2 & 7, b = j2 >> 3;
      attn_block<3, false, 2>(QA + h * 96, 768, KA + (size_t)h * TP * 96, 96, VT + (size_t)(8 + h) * VCHUNKS * 4096, AX + C0_GA + h * 64, LD0, Y + h * 64,
                           b * 256, b * 256, 4, 0, 0, false, 0.f, 0, 0, lds, kmax[1]);
    } else {
      const int j2 = it - E_CA;
      const int h = j2 & 7, b = j2 >> 3;
      attn_block<2, false, 2>(AX + C0_QB + h * 64, LD0, (const bfraw*)(p.ws + WS_KH) + (size_t)h * TP * 64, 64, VT + (size_t)h * VCHUNKS * 4096, AX + C0_GB + h * 64, LD0, Y + 512 + h * 64,
                           b * 256, b * 256, 4, 0, 0, false, 0.f, 0, 0, lds, kmax[0]);
    }
  }
  __builtin_amdgcn_s_setprio(0);
}

__device__ __forceinline__ void phase_attn1(const Params& p, unsigned char* ldsraw) {
  bfraw* lds = (bfraw*)ldsraw;
  const bfraw* AX = (const bfraw*)(p.ws + WS_AX);
  const bfraw* VT = (const bfraw*)(p.ws + WS_VT);
  bfraw* Y = (bfraw*)(p.ws + WS_HY);
  const float* kmax = (const float*)(p.ws + WS_KMAX);
  const int wave = phase_tid() >> 6;
  if (__builtin_amdgcn_readfirstlane(wave) >= 4) __builtin_amdgcn_s_setprio(1);
  constexpr int N_LC = 128, N_LD = 128, N_CC = 256, N_CD = 256;
  constexpr int E_LC = N_LC, E_LD = E_LC + N_LD, E_CC = E_LD + N_CC, E_CD = E_CC + N_CD;
  const float* sink = p.in[I_SINK];
  for (int it = blockIdx.x; it < E_CD; it += gridDim.x) {
    if (it < E_LC) {
      const int qb = it & 7, h = (it >> 3) & 7, b = it >> 6;
      const int kv = h >> 2;
      attn_block<2, false, 1>(AX + C1_QC + h * 64, LD1, (const bfraw*)(p.ws + WS_KH) + (size_t)kv * TP * 64, 64, VT + (size_t)kv * VCHUNKS * 4096, AX + C1_GC + h * 64, LD1, Y + h * 64,
                           T_CTX + b * 1024 + qb * 128, T_CTX + b * 1024, 16, T_ALL + b * 256, 4, false, 0.f, 0, 0, lds, fmaxf(kmax[2], kmax[24 + b * 2 + kv]));
    } else if (it < E_LD) {
      const int j2 = it - E_LC;
      const int qb = j2 & 7, h = (j2 >> 3) & 7, b = j2 >> 6;
      const int kv = h >> 2;
      const int q0 = qb * 128;
      int klo = q0 - 128; klo = klo < 0 ? 0 : klo;
      int khi = q0 + 256; khi = khi > 1024 ? 1024 : khi;
      attn_block<2, true, 1>(AX + C1_QD + h * 64, LD1, (const bfraw*)(p.ws + WS_KH) + (size_t)(2 + kv) * TP * 64, 64, VT + (size_t)(2 + kv) * VCHUNKS * 4096, AX + C1_GD + h * 64, LD1, Y + 512 + h * 64,
                          T_CTX + b * 1024 + q0, T_CTX + b * 1024 + klo, (khi - klo) >> 6, T_ALL + b * 256, 4, true, sink[h], q0 + wave * 16, klo, lds, fmaxf(kmax[3], kmax[28 + b * 2 + kv]));
    } else if (it < E_CC) {
      const int j2 = it - E_LD;
      const int h = j2 & 7, b = j2 >> 3;
      const int kv = h >> 2;
      attn_block<2, false, 2>(AX + C1_QC + h * 64, LD1, (const bfraw*)(p.ws + WS_KH) + (size_t)kv * TP * 64, 64, VT + (size_t)kv * VCHUNKS * 4096, AX + C1_GC + h * 64, LD1, Y + h * 64,
                           b * 256, b * 256, 4, 0, 0, false, 0.f, 0, 0, lds, kmax[2]);
    } else {
      const int j2 = it - E_CC;
      const int h = j2 & 7, b = j2 >> 3;
      const int kv = h >> 2;
      attn_block<2, false, 2>(AX + C1_QD + h * 64, LD1, (const bfraw*)(p.ws + WS_KH) + (size_t)(2 + kv) * TP * 64, 64, VT + (size_t)(2 + kv) * VCHUNKS * 4096, AX + C1_GD + h * 64, LD1, Y + 512 + h * 64,
                           b * 256, b * 256, 4, 0, 0, true, sink[h], 0, 0, lds, kmax[3]);
    }
  }
  __builtin_amdgcn_s_setprio(0);
}

#define XB_TMO      128
#define XB_XCNT(j)  (256  + 64 * (j))
#define XB_XSUB(j)  (1280 + 64 * (j))
#define XB_XGEN(j)  (2304 + 64 * (j))
#define XB_TOP      3328
#define XB_TOPGEN   3392
#define XCD_BAR_WORDS 3456
#define XB_SPIN_CAP (1u << 22)
#define LAS __attribute__((address_space(3)))
__device__ __forceinline__ unsigned xb_ld(unsigned* p)              { return __hip_atomic_load(p, __ATOMIC_RELAXED, __HIP_MEMORY_SCOPE_AGENT); }
__device__ __forceinline__ unsigned xb_add(unsigned* p, unsigned v) { return __hip_atomic_fetch_add(p, v, __ATOMIC_RELAXED, __HIP_MEMORY_SCOPE_AGENT); }
__device__ __forceinline__ unsigned xb_xcc_id() { return (unsigned)__builtin_amdgcn_s_getreg((3 << 11) | 20) & 0xFu; }
#define XB_SPIN(cond, bar) do { unsigned _sp = 0; while (cond) { __builtin_amdgcn_s_sleep(1); \
    if ((++_sp & 255u) == 0u) { if (xb_ld(&(bar)[XB_TMO])) break; if (_sp > XB_SPIN_CAP) { atomicAdd(&(bar)[XB_TMO], 1u); break; } } } } while (0)
struct XcdBarrier { unsigned* bar; unsigned x; volatile LAS unsigned* st; };
__device__ __forceinline__ XcdBarrier xcd_barrier_post(unsigned* bar, volatile LAS unsigned* st) {
  XcdBarrier b; b.bar = bar; b.x = xb_xcc_id(); b.st = st;
  if (threadIdx.x == 0) (void)xb_add(&bar[XB_XCNT(b.x)], 1u);
  return b;
}
__device__ __forceinline__ void xcd_barrier_complete(unsigned* bar, unsigned x, unsigned& nloc, unsigned& nx) {
  const unsigned G = gridDim.x * gridDim.y * gridDim.z;
  unsigned sum, cnt, mine, sp = 0u;
  for (;;) {
    sum = 0u; cnt = 0u; mine = 0u;
#pragma unroll
    for (unsigned j = 0; j < 16; ++j) { const unsigned c = xb_ld(&bar[XB_XCNT(j)]); sum += c; cnt += (c > 0u) ? 1u : 0u; mine = (j == x) ? c : mine; }
    if (sum == G) break;
    __builtin_amdgcn_s_sleep(1);
    if ((++sp & 255u) == 0u) { if (xb_ld(&bar[XB_TMO])) break; if (sp > XB_SPIN_CAP) { atomicAdd(&bar[XB_TMO], 1u); break; } }
  }
  nloc = mine > 0u ? mine : 1u; nx = cnt > 0u ? cnt : 1u;
}
__device__ __forceinline__ void xcd_barrier(const XcdBarrier& b) {
  asm volatile("s_waitcnt vmcnt(0)" ::: "memory");
  __syncthreads();
  if (threadIdx.x == 0) {
    unsigned* bar = b.bar;
    __builtin_amdgcn_s_waitcnt(0);
    unsigned nloc = b.st[0], nx = b.st[1];
    if (nloc == 0u) { xcd_barrier_complete(bar, b.x, nloc, nx); b.st[0] = nloc; b.st[1] = nx; }
    const unsigned old = xb_add(&bar[XB_XSUB(b.x)], 1u);
    const unsigned gen = old / nloc;
    if (old + 1u == (gen + 1u) * nloc) {
      __builtin_amdgcn_fence(__ATOMIC_RELEASE, "agent");
      asm volatile("s_waitcnt vmcnt(0)" ::: "memory");
      const unsigned og = xb_add(&bar[XB_TOP], 1u);
      const unsigned tg = og / nx;
      if (og + 1u == (tg + 1u) * nx) xb_add(&bar[XB_TOPGEN], 1u);
      else XB_SPIN(xb_ld(&bar[XB_TOPGEN]) == tg, bar);
      __builtin_amdgcn_fence(__ATOMIC_ACQUIRE, "agent");
      xb_add(&bar[XB_XGEN(b.x)], 1u);
      asm volatile("s_waitcnt vmcnt(0)" ::: "memory");
    } else {
      XB_SPIN(xb_ld(&bar[XB_XGEN(b.x)]) == gen, bar);
      __builtin_amdgcn_fence(__ATOMIC_ACQUIRE, "agent");
      asm volatile("s_waitcnt vmcnt(0)" ::: "memory");
    }
  }
  __syncthreads();
}

__device__ __forceinline__ void run_phase(const Params& p, int ph, unsigned char* lds) {
  switch (ph) {
    case 0: phase_prep0(p, lds); break;
    case 1: phase_modulate(p, 0, lds); break;
    case 2: phase_gemm_in0(p, lds); break;
    case 3: phase_up0(p, lds); break;
    case 4: phase_attn0(p, lds); break;
    case 5: phase_gemm_out(p, 0, lds); break;
    case 6: phase_modulate(p, 1, lds); break;
    case 7: phase_gemm_in1(p, lds); break;
    case 8: phase_attn1(p, lds); break;
    case 9: phase_gemm_out(p, 1, lds); break;
  }
}

__device__ __forceinline__ const Params* launder_params(const Params* q) { asm volatile("" : "+s"(q) :: "memory"); return q; }

#if MULTI_LAUNCH
template <int PH>
__global__ void __launch_bounds__(NT, 2) k_phase(Params p) {
  __shared__ __attribute__((aligned(16))) unsigned char lds[LDS_BYTES];
  run_phase(p, PH, lds);
}
template <int PH>
static void launch_phases(const Params& p, hipStream_t stream) {
  hipLaunchKernelGGL(k_phase<PH>, dim3(256), dim3(NT), 0, stream, p);
  if constexpr (PH < 9) launch_phases<PH + 1>(p, stream);
}
#else
__global__ void __launch_bounds__(NT, 2) k_mega(Params p) {
  __shared__ __attribute__((aligned(16))) unsigned char lds[LDS_BYTES];
  __shared__ uint4 xb_words;
  cg::grid_group grid = cg::this_grid();
  if (threadIdx.x == 0) xb_words = make_uint4(0u, 0u, 0u, 0u);
  __syncthreads();
  XcdBarrier xb = xcd_barrier_post((unsigned*)(p.ws + WS_BAR), (volatile LAS unsigned*)&xb_words);
#define SEAM() do { if (p.sync_mode) grid.sync(); else xcd_barrier(xb); } while (0)
#ifndef DUP_PHASE
#define DUP_PHASE -1
#endif
#define PP p
#define RUN(ph, call) do { call; SEAM(); if (DUP_PHASE == ph) { call; SEAM(); } } while (0)
  RUN(0, phase_prep0(PP, lds));
  RUN(1, phase_modulate(PP, 0, lds));
  RUN(2, phase_gemm_in0(PP, lds));
  RUN(3, phase_up0(PP, lds));
  RUN(4, phase_attn0(PP, lds));
  RUN(5, phase_gemm_out(PP, 0, lds));
  RUN(6, phase_modulate(PP, 1, lds));
  RUN(7, phase_gemm_in1(PP, lds));
  RUN(8, phase_attn1(PP, lds));
  phase_gemm_out(PP, 1, lds);
  if (DUP_PHASE == 9) { SEAM(); phase_gemm_out(PP, 1, lds); }
}
#endif

extern "C" void kernel_launch(void* const* d_in, const int* in_sizes, int n_in, void* d_out, int out_size, void* d_ws, size_t ws_size,
                              hipStream_t stream) {
  Params p{};
  for (int i = 0; i < 33; ++i) p.in[i] = (const float*)d_in[i];
  p.out = (float*)d_out;
  p.ws = (unsigned char*)d_ws;
  if (ws_size < WS_END) { fprintf(stderr, "workspace too small: %zu < %llu\n", ws_size, (unsigned long long)WS_END); return; }
#if MULTI_LAUNCH
  launch_phases<0>(p, stream);
#else
  static int grid_blocks = 0;
  if (!grid_blocks) {
    int dev = 0, cus = 0, per_cu = 0;
    (void)hipGetDevice(&dev);
    (void)hipDeviceGetAttribute(&cus, hipDeviceAttributeMultiprocessorCount, dev);
    (void)hipOccupancyMaxActiveBlocksPerMultiprocessor(&per_cu, k_mega, NT, 0);
    per_cu = 1;
    grid_blocks = cus * per_cu;
  }
  void* args[] = {&p};
  (void)hipMemsetAsync((unsigned char*)d_ws + WS_BAR, 0, XCD_BAR_WORDS * 4, stream);
  hipError_t e = hipLaunchCooperativeKernel((void*)k_mega, dim3(grid_blocks), dim3(NT), args, 0, stream);
  if (e != hipSuccess) fprintf(stderr, "cooperative launch failed: %s (grid %d)\n", hipGetErrorString(e), grid_blocks);
#endif
}
```

```cpp
#include <hip/hip_runtime.h>
#include <hip/hip_cooperative_groups.h>
#include <cstdio>
#include <type_traits>
namespace cg = cooperative_groups;

typedef __attribute__((ext_vector_type(8))) __bf16 bf16x8;
typedef __attribute__((ext_vector_type(4))) float f32x4;
typedef unsigned short bfraw;

#ifndef MULTI_LAUNCH
#define MULTI_LAUNCH 0
#endif

#define T_CTX 8192
#define T_LAT 2048
#define T_ALL 10240
#define TP 10752
#define DM 1024
#define EPSF 1e-6f
#define LOG2E 1.4426950408889634f
#define LD0 3072
#define LD1 2560
#define C0_QB 0
#define C0_KB 512
#define C0_VB 1024
#define C0_GA 1536
#define C0_GB 2048
#define C0_QLAT 2560
#define C0_CKV 2816
#define C0_KROPE 2944
#define C1_QC 0
#define C1_KC 512
#define C1_VC 640
#define C1_GC 768
#define C1_QD 1280
#define C1_KD 1792
#define C1_VD 1920
#define C1_GD 2048

#define WS_WIN0   0ull
#define WS_WIN1   (WS_WIN0 + 3072ull*1024*2)
#define WS_WOUT0  (WS_WIN1 + 2560ull*1024*2)
#define WS_WOUT1  (WS_WOUT0 + 1024ull*1024*2)
#define WS_WQUP   (WS_WOUT1 + 1024ull*1024*2)
#define WS_WKVUP  (WS_WQUP + 768ull*256*2)
#define WS_MODF   (WS_WKVUP + 1024ull*128*2)
#define WS_COSA   (WS_MODF + 2ull*3*3072*4)
#define WS_SINA   (WS_COSA + 1024ull*16*4)
#define WS_COSH   (WS_SINA + 1024ull*16*4)
#define WS_SINH   (WS_COSH + 1024ull*32*4)
#define WS_HY     (WS_SINH + 1024ull*32*4)
#define WS_AX     (WS_HY + 10240ull*1024*2)
#define WS_VT     (WS_AX + 10752ull*3072*2)
#define WS_QA     (WS_VT + 1024ull*10752*2)
#define WS_KA     (WS_QA + 10240ull*768*2)
#define WS_KROPE  (WS_KA + 10752ull*768*2)
#define WS_QSS    (WS_KROPE + 10752ull*32*4)
#define WS_CKSS   (WS_QSS + 10240ull*4*4)
#define WS_WKVUP2 (WS_CKSS + 10240ull*2*4)
#define WS_KMAX   (WS_WKVUP2 + 1024ull*128*2)
#define WS_KH     (WS_KMAX + 256ull)
#define WS_X1     (WS_KH + 8ull*10752*64*2)
#define WS_BAR    (WS_X1 + 10240ull*1024*4)
#define WS_END    (WS_BAR + 16384ull)

#define O_YP   0ull
#define O_YS   8388608ull
#define O_CKV  10485760ull
#define O_KROPE 11534336ull
#define O_NAK  11796480ull
#define O_NAV  15990784ull
#define O_GQK  20185088ull
#define O_GQV  21233664ull
#define O_SWK  22282240ull
#define O_SWV  23330816ull

struct Params {
  const float* in[33];
  float* out;
  unsigned char* ws;
  int sync_mode;
  int pad_;
};
enum { I_XP = 0, I_XS, I_CCKV, I_CKROPE, I_CNAK, I_CNAV, I_CGQK, I_CGQV, I_CSWK, I_CSWV, I_C, I_CCTX, I_NORMG, I_WMOD, I_BMOD,
       I_WINE, I_QAG, I_WQUP, I_KVAG, I_WKVUP, I_MQG, I_MKG, I_NAQG, I_NAKG, I_RPB, I_WOUTE, I_WINO, I_GQG, I_GKG, I_SQG, I_SKG, I_SINK, I_WOUTO };

__device__ __forceinline__ bfraw f2bf(float f) { __bf16 h = (__bf16)f; return __builtin_bit_cast(bfraw, h); }
typedef __attribute__((ext_vector_type(2))) float f32x2_t;
typedef __attribute__((ext_vector_type(2))) __bf16 bf16x2_t;
__device__ __forceinline__ unsigned pack2(float a, float b) { const f32x2_t v = {a, b}; return __builtin_bit_cast(unsigned, __builtin_convertvector(v, bf16x2_t)); }
__device__ __forceinline__ float bf2f(unsigned h) { return __uint_as_float(h << 16); }
__device__ __forceinline__ float silu_f(float x) { return x / (1.f + __expf(-x)); }
__device__ __forceinline__ float quad_sum(float v) { v += __shfl_xor(v, 16); v += __shfl_xor(v, 32); return v; }
__device__ __forceinline__ float quad_max(float v) { v = fmaxf(v, __shfl_xor(v, 16)); v = fmaxf(v, __shfl_xor(v, 32)); return v; }
__device__ __forceinline__ f32x4 mfma16(bf16x8 a, bf16x8 b, f32x4 c) { return __builtin_amdgcn_mfma_f32_16x16x32_bf16(a, b, c, 0, 0, 0); }
__device__ __forceinline__ uint2 pack4(f32x4 v) { uint2 u; u.x = pack2(v[0], v[1]); u.y = pack2(v[2], v[3]); return u; }

#define VCHUNKS 168
__device__ __forceinline__ size_t vc_off(int head, int tok, int f) { return (((size_t)head * VCHUNKS + (tok >> 6)) * 64 + f) * 64 + (tok & 63); }
__device__ __forceinline__ f32x4 ld_nt4(const float* p) { return __builtin_nontemporal_load((const f32x4*)p); }
__device__ __forceinline__ void st_nt4(float* p, f32x4 v) { __builtin_nontemporal_store(v, (f32x4*)p); }
__device__ __forceinline__ f32x4 ld_bf16x4(const bfraw* p) {
  const uint2 u = *(const uint2*)p;
  return f32x4{bf2f(u.x & 0xffffu), bf2f(u.x >> 16), bf2f(u.y & 0xffffu), bf2f(u.y >> 16)};
}
#define LDSK 64
#define NT 512
#define LDS_BYTES 131072

__device__ __forceinline__ int phase_tid() { int t = threadIdx.x; asm volatile("" : "+v"(t)); return t; }

template <int TN, int TM, int WN, int WM>
__device__ __forceinline__ void gemm_mainloop(const bfraw* __restrict__ Wt, int ldw, const bfraw* __restrict__ Act, int lda,
                                              int n0, int m0, int K, bfraw* lds, f32x4 (&acc)[TN][TM]) {
  static_assert(WN * WM == 8, "8 waves");
  constexpr int BN = TN * WN * 16, BM = TM * WM * 16;
  constexpr int NCW = (BN * 8 + NT - 1) / NT, NCA = (BM * 8 + NT - 1) / NT;
  const int tid = phase_tid(), lane = tid & 63, wave = tid >> 6;
  const int wn = wave % WN, wm = wave / WN;
  const int r16 = lane & 15, q4 = lane >> 4;
  bfraw* ldsW = lds;
  bfraw* ldsA = lds + 2 * BN * LDSK;
#pragma unroll
  for (int i = 0; i < TN; ++i)
#pragma unroll
    for (int j = 0; j < TM; ++j) acc[i][j] = f32x4{0.f, 0.f, 0.f, 0.f};
  uint4 rw[NCW], ra[NCA];
  const int KT = K / 64;
  auto gload = [&](int k0) {
#pragma unroll
    for (int i = 0; i < NCW; ++i) { int c = tid + NT * i; if (c >= BN * 8) c = BN * 8 - 1; int row = c >> 3, kc = c & 7; rw[i] = *(const uint4*)(Wt + (size_t)(n0 + row) * ldw + k0 + kc * 8); }
#pragma unroll
    for (int i = 0; i < NCA; ++i) { int c = tid + NT * i; if (c >= BM * 8) c = BM * 8 - 1; int row = c >> 3, kc = c & 7; ra[i] = *(const uint4*)(Act + (size_t)(m0 + row) * lda + k0 + kc * 8); }
  };
  auto lstore = [&](int buf) {
#pragma unroll
    for (int i = 0; i < NCW; ++i) { int c = tid + NT * i; if (c < BN * 8) { int row = c >> 3, kc = (c & 7) ^ ((row >> 1) & 7); *(uint4*)(ldsW + (buf * BN + row) * LDSK + kc * 8) = rw[i]; } }
#pragma unroll
    for (int i = 0; i < NCA; ++i) { int c = tid + NT * i; if (c < BM * 8) { int row = c >> 3, kc = (c & 7) ^ ((row >> 1) & 7); *(uint4*)(ldsA + (buf * BM + row) * LDSK + kc * 8) = ra[i]; } }
  };
  __syncthreads();
  gload(0);
  lstore(0);
  __syncthreads();
  for (int kt = 0; kt < KT; ++kt) {
    const int buf = kt & 1;
    gload(((kt + 1 < KT) ? kt + 1 : kt) * 64);
    const bfraw* bw = ldsW + (buf * BN + wn * TN * 16 + r16) * LDSK;
    const bfraw* ba = ldsA + (buf * BM + wm * TM * 16 + r16) * LDSK;
#pragma unroll
    for (int ks = 0; ks < 2; ++ks) {
      bf16x8 fw[TN], fa[TM];
      const int sw = ((ks * 4 + q4) ^ (r16 >> 1)) * 8;
#pragma unroll
      for (int i = 0; i < TN; ++i) fw[i] = *(const bf16x8*)(bw + i * 16 * LDSK + sw);
#pragma unroll
      for (int j = 0; j < TM; ++j) fa[j] = *(const bf16x8*)(ba + j * 16 * LDSK + sw);
#pragma unroll
      for (int i = 0; i < TN; ++i)
#pragma unroll
        for (int j = 0; j < TM; ++j) acc[i][j] = mfma16(fw[i], fa[j], acc[i][j]);
    }
    lstore(buf ^ 1);
    __syncthreads();
  }
}

template <int I, int N, class F>
__device__ __forceinline__ void static_for(F&& f) { if constexpr (I < N) { f(std::integral_constant<int, I>{}); static_for<I + 1, N>(f); } }

template <int TN, int TM, int WN, int WM, int KT>
__device__ __forceinline__ void gemm_smallk(const bfraw* __restrict__ Wt, int ldw, const bfraw* __restrict__ Act, int lda,
                                            int n0, int m0, bfraw* lds, f32x4 (&acc)[TN][TM]) {
  static_assert(WN * WM == 8, "8 waves");
  constexpr int BN = TN * WN * 16, BM = TM * WM * 16;
  constexpr int NCW = (BN * 8 + NT - 1) / NT, NCA = (BM * 8 + NT - 1) / NT;
  const int tid = phase_tid(), lane = tid & 63, wave = tid >> 6;
  const int wn = wave % WN, wm = wave / WN;
  const int r16 = lane & 15, q4 = lane >> 4;
  bfraw* ldsW = lds;
  bfraw* ldsA = lds + 2 * BN * LDSK;
#pragma unroll
  for (int i = 0; i < TN; ++i)
#pragma unroll
    for (int j = 0; j < TM; ++j) acc[i][j] = f32x4{0.f, 0.f, 0.f, 0.f};
  static_assert(NCW == 2 && NCA == 4, "two W chunks and four A chunks per thread");
  uint4 w00, w01, a00, a01, a02, a03, w10, w11, a10, a11, a12, a13;
  auto ldw1 = [&](int kt, int i) -> uint4 { int c = tid + NT * i; if (c >= BN * 8) c = BN * 8 - 1; const int row = c >> 3, kc = c & 7; return *(const uint4*)(Wt + (size_t)(n0 + row) * ldw + kt * 64 + kc * 8); };
  auto lda1 = [&](int kt, int i) -> uint4 { const int c = tid + NT * i; const int row = c >> 3, kc = c & 7; return *(const uint4*)(Act + (size_t)(m0 + row) * lda + kt * 64 + kc * 8); };
  auto stw1 = [&](int buf, int i, const uint4& v) { const int c = tid + NT * i; if (c < BN * 8) { const int row = c >> 3, kc = (c & 7) ^ ((row >> 1) & 7); *(uint4*)(ldsW + (buf * BN + row) * LDSK + kc * 8) = v; } };
  auto sta1 = [&](int buf, int i, const uint4& v) { const int c = tid + NT * i; const int row = c >> 3, kc = (c & 7) ^ ((row >> 1) & 7); *(uint4*)(ldsA + (buf * BM + row) * LDSK + kc * 8) = v; };
#define SK_LOAD0(kt) do { w00 = ldw1(kt, 0); w01 = ldw1(kt, 1); a00 = lda1(kt, 0); a01 = lda1(kt, 1); a02 = lda1(kt, 2); a03 = lda1(kt, 3); } while (0)
#define SK_LOAD1(kt) do { w10 = ldw1(kt, 0); w11 = ldw1(kt, 1); a10 = lda1(kt, 0); a11 = lda1(kt, 1); a12 = lda1(kt, 2); a13 = lda1(kt, 3); } while (0)
#define SK_STAGE0(buf) do { stw1(buf, 0, w00); stw1(buf, 1, w01); sta1(buf, 0, a00); sta1(buf, 1, a01); sta1(buf, 2, a02); sta1(buf, 3, a03); } while (0)
#define SK_STAGE1(buf) do { stw1(buf, 0, w10); stw1(buf, 1, w11); sta1(buf, 0, a10); sta1(buf, 1, a11); sta1(buf, 2, a12); sta1(buf, 3, a13); } while (0)
#define SK_COMPUTE(buf) do { \
    const bfraw* bw = ldsW + ((buf) * BN + wn * TN * 16 + r16) * LDSK; const bfraw* ba = ldsA + ((buf) * BM + wm * TM * 16 + r16) * LDSK; \
    _Pragma("unroll") for (int ks = 0; ks < 2; ++ks) { bf16x8 fw[TN], fa[TM]; const int sw = ((ks * 4 + q4) ^ (r16 >> 1)) * 8; \
      _Pragma("unroll") for (int i = 0; i < TN; ++i) fw[i] = *(const bf16x8*)(bw + i * 16 * LDSK + sw); \
      _Pragma("unroll") for (int j = 0; j < TM; ++j) fa[j] = *(const bf16x8*)(ba + j * 16 * LDSK + sw); \
      _Pragma("unroll") for (int i = 0; i < TN; ++i) _Pragma("unroll") for (int j = 0; j < TM; ++j) acc[i][j] = mfma16(fw[i], fa[j], acc[i][j]); } } while (0)
  static_assert(KT == 2 || KT == 4, "KT is 2 or 4");
  SK_LOAD0(0); SK_LOAD1(1);
  __syncthreads();
  SK_STAGE0(0);
  if constexpr (KT == 4) SK_LOAD0(2);
  __syncthreads();
  SK_STAGE1(1); SK_COMPUTE(0);
  if constexpr (KT == 4) SK_LOAD1(3);
  __syncthreads();
  if constexpr (KT == 4) {
    SK_STAGE0(0); SK_COMPUTE(1);
    __syncthreads();
    SK_STAGE1(1); SK_COMPUTE(0);
    __syncthreads();
  }
  SK_COMPUTE(1);
#undef SK_LOAD0
#undef SK_LOAD1
#undef SK_STAGE0
#undef SK_STAGE1
#undef SK_COMPUTE
}

__device__ __forceinline__ void head_norm64(f32x4 (&acc)[4][4], const float* __restrict__ g, float post, int q4) {
  f32x4 gv[4];
#pragma unroll
  for (int tn = 0; tn < 4; ++tn) gv[tn] = *(const f32x4*)(g + tn * 16 + q4 * 4);
#pragma unroll
  for (int tm = 0; tm < 4; ++tm) {
    float ss = 0.f;
#pragma unroll
    for (int tn = 0; tn < 4; ++tn)
#pragma unroll
      for (int r = 0; r < 4; ++r) ss += acc[tn][tm][r] * acc[tn][tm][r];
    ss = quad_sum(ss);
    const float rs = rsqrtf(ss * (1.f / 64.f) + EPSF) * post;
#pragma unroll
    for (int tn = 0; tn < 4; ++tn)
#pragma unroll
      for (int r = 0; r < 4; ++r) acc[tn][tm][r] *= rs * gv[tn][r];
    __builtin_amdgcn_sched_barrier(0);
  }
}
__device__ __forceinline__ void rope64(f32x4 (&acc)[4][4], const float* __restrict__ cosH, const float* __restrict__ sinH, int mw, int r16, int q4) {
#pragma unroll
  for (int tm = 0; tm < 4; ++tm) {
    const int pos = (mw + tm * 16 + r16 - T_CTX) & 1023;
#pragma unroll
    for (int tn = 0; tn < 2; ++tn) {
      const f32x4 c = *(const f32x4*)(cosH + pos * 32 + tn * 16 + q4 * 4);
      const f32x4 s = *(const f32x4*)(sinH + pos * 32 + tn * 16 + q4 * 4);
#pragma unroll
      for (int r = 0; r < 4; ++r) {
        const float x1 = acc[tn][tm][r], x2 = acc[tn + 2][tm][r];
        acc[tn][tm][r] = x1 * c[r] - x2 * s[r];
        acc[tn + 2][tm][r] = x1 * s[r] + x2 * c[r];
      }
    }
    __builtin_amdgcn_sched_barrier(0);
  }
}
__device__ __forceinline__ void store_rows_bf16(const f32x4 (&acc)[4][4], bfraw* __restrict__ dst, int ld, int col0, int mw, int r16, int q4) {
#pragma unroll
  for (int tm = 0; tm < 4; ++tm) {
    bfraw* p = dst + (size_t)(mw + tm * 16 + r16) * ld + col0 + q4 * 4;
#pragma unroll
    for (int tn = 0; tn < 4; ++tn) *(uint2*)(p + tn * 16) = pack4(acc[tn][tm]);
    __builtin_amdgcn_sched_barrier(0);
  }
}
__device__ __forceinline__ void store_vt(const f32x4 (&acc)[4][4], bfraw* __restrict__ vt, int row0, int mw, int r16, int q4) {
#pragma unroll
  for (int tm = 0; tm < 4; ++tm)
#pragma unroll
    for (int tn = 0; tn < 4; ++tn)
#pragma unroll
      for (int r = 0; r < 4; ++r) vt[(size_t)(row0 + tn * 16 + q4 * 4 + r) * TP + mw + tm * 16 + r16] = f2bf(acc[tn][tm][r]);
}
__device__ __forceinline__ void store_cache_f32(const f32x4 (&acc)[4][4], float* __restrict__ o, int nh, int hh, int mw, int r16, int q4) {
#pragma unroll
  for (int tm = 0; tm < 4; ++tm) {
    const int tok = mw + tm * 16 + r16;
    const int b = tok >> 8, s = tok & 255;
    float* p = o + ((size_t)(b * nh + hh) * 256 + s) * 64 + q4 * 4;
#pragma unroll
    for (int tn = 0; tn < 4; ++tn) *(f32x4*)(p + tn * 16) = acc[tn][tm];
    __builtin_amdgcn_sched_barrier(0);
  }
}

__device__ __forceinline__ int in0_src_col(int l) {
  if (l < 512) return 928 + l;
  if (l < 1024) return 1440 + (l - 512);
  if (l < 1536) return 1952 + (l - 1024);
  if (l < 2048) return 416 + (l - 1536);
  if (l < 2560) return 2464 + (l - 2048);
  if (l < 2816) return l - 2560;
  if (l < 2944) return 256 + (l - 2816);
  if (l < 2976) return 384 + (l - 2944);
  return -1;
}
__device__ __forceinline__ void transpose_item(const float* __restrict__ src, int ld_src, int srccol0, int ncols_valid, bfraw* __restrict__ dst, int K, int nd0, int k0,
                               const float* __restrict__ kscale, float* tile  , int perm_unit = -1, int mode = 0) {
  const int tid = phase_tid();
  const int tx = tid & 63, ty = tid >> 6;
  if (perm_unit >= 0) {
    const int k = (nd0 >> 6) & 3;
    const int l = perm_unit * 256 + (((k & 1) * 2 + (tx >> 5)) * 64) + (k >> 1) * 32 + (tx & 31);
    const int sc = mode ? in0_src_col(l) : l;
    srccol0 = sc - tx;
    ncols_valid = (sc >= 0) ? 64 : 0;
  }
  float v[2][8];
#pragma unroll
  for (int h = 0; h < 2; ++h)
#pragma unroll
    for (int i = 0; i < 8; ++i) {
      const int kk = k0 + h * 64 + ty * 8 + i;
      float x = 0.f;
      if (tx < ncols_valid) {
        x = __builtin_nontemporal_load(src + (size_t)kk * ld_src + srccol0 + tx);
        if (kscale) x *= kscale[kk];
      }
      v[h][i] = x;
    }
#pragma unroll
  for (int h = 0; h < 2; ++h) {
    __syncthreads();
#pragma unroll
    for (int i = 0; i < 8; ++i) tile[(ty * 8 + i) * 65 + tx] = v[h][i];
    __syncthreads();
    const int nl = tid >> 3, kc = tid & 7;
    uint4 u;
    u.x = pack2(tile[(kc * 8 + 0) * 65 + nl], tile[(kc * 8 + 1) * 65 + nl]);
    u.y = pack2(tile[(kc * 8 + 2) * 65 + nl], tile[(kc * 8 + 3) * 65 + nl]);
    u.z = pack2(tile[(kc * 8 + 4) * 65 + nl], tile[(kc * 8 + 5) * 65 + nl]);
    u.w = pack2(tile[(kc * 8 + 6) * 65 + nl], tile[(kc * 8 + 7) * 65 + nl]);
    *(uint4*)(dst + (size_t)(nd0 + nl) * K + k0 + h * 64 + kc * 8) = u;
  }
}

__device__ __forceinline__ void mod_item(const Params& p, int l, int col0, float* ldsf) {
  const int tid = phase_tid();
  float* sc = ldsf;
  float* red = ldsf + 3072;
  __syncthreads();
  for (int i = tid; i < 3072; i += NT) {
    const int cnd = i >> 10, k = i & 1023;
    const float v = (cnd == 0) ? p.in[I_CCTX][k] : p.in[I_C][(cnd - 1) * 1024 + k];
    sc[i] = silu_f(v);
  }
  __syncthreads();
  const int cg8 = tid & 7, kl = tid >> 3;
  float a[3][4];
#pragma unroll
  for (int c = 0; c < 3; ++c)
#pragma unroll
    for (int j = 0; j < 4; ++j) a[c][j] = 0.f;
  const float* wm = p.in[I_WMOD] + (size_t)l * 1024 * 3072 + col0 + cg8 * 4;
#pragma unroll
  for (int i = 0; i < 16; ++i) {
    const int k = kl + 64 * i;
    const f32x4 w = ld_nt4(wm + (size_t)k * 3072);
#pragma unroll
    for (int c = 0; c < 3; ++c) {
      const float s = sc[c * 1024 + k];
#pragma unroll
      for (int j = 0; j < 4; ++j) a[c][j] += s * w[j];
    }
  }
#pragma unroll
  for (int c = 0; c < 3; ++c)
#pragma unroll
    for (int j = 0; j < 4; ++j) red[(kl * 8 + cg8) * 12 + c * 4 + j] = a[c][j];
  __syncthreads();
  if (tid < 96) {
    const int cnd = tid >> 5, col = tid & 31;
    float s = p.in[I_BMOD][l * 3072 + col0 + col];
    for (int k2 = 0; k2 < 64; ++k2) s += red[(k2 * 8 + (col >> 2)) * 12 + cnd * 4 + (col & 3)];
    ((float*)(p.ws + WS_MODF))[(l * 3 + cnd) * 3072 + col0 + col] = s;
  }
}

__device__ __forceinline__ void phase_prep0(const Params& p, unsigned char* ldsraw) {
  float* ldsf = (float*)ldsraw;
  const int tid = phase_tid();
  constexpr int N_MOD = 96, N_WIN0 = 384, N_WIN1 = 0, N_WOUT = 128, N_QUP = 24, N_KVUP = 32, N_ROPE = 0, N_CACHE = 0;
  constexpr int E_MOD = N_MOD, E_WIN0 = E_MOD + N_WIN0, E_WIN1 = E_WIN0 + N_WIN1, E_WOUT = E_WIN1 + N_WOUT, E_QUP = E_WOUT + N_QUP,
                E_KVUP = E_QUP + N_KVUP, E_ROPE = E_KVUP + N_ROPE, E_CACHE = E_ROPE + N_CACHE;
  bfraw* AX = (bfraw*)(p.ws + WS_AX);
  bfraw* VT = (bfraw*)(p.ws + WS_VT);
  float sink_v = 0.f;
  {
    const size_t NLP = 8388608 / 16, NLS = 2097152 / 16;
    for (size_t i = (size_t)blockIdx.x * NT + tid; i < NLP + NLS; i += (size_t)gridDim.x * NT)
      sink_v += (i < NLP) ? p.in[I_XP][i * 16] : p.in[I_XS][(i - NLP) * 16];
  }
  for (int it = blockIdx.x; it < E_CACHE; it += gridDim.x) {
    if (it < E_MOD) {
      mod_item(p, 0, it * 32, ldsf);
    } else if (it < E_WIN0) {
      const int j = it - E_MOD;
      const int nt = j % 48, kt = j / 48;
      const int nd0 = nt * 64;
      transpose_item(p.in[I_WINE], 2976, 0, 64, (bfraw*)(p.ws + WS_WIN0), 1024, nd0, kt * 128, nullptr, ldsf, nd0 >> 8, 1);
    } else if (it < E_WOUT) {
      const int j = it - E_WIN1;
      const int nt = j % 16, kt = j / 16;
      transpose_item(p.in[I_WOUTE], 1024, nt * 64, 64, (bfraw*)(p.ws + WS_WOUT0), 1024, nt * 64, kt * 128, nullptr, ldsf);
    } else if (it < E_QUP) {
      const int j = it - E_WOUT;
      const int nt = j % 12, kt = j / 12;
      transpose_item(p.in[I_WQUP], 768, nt * 64, 64, (bfraw*)(p.ws + WS_WQUP), 256, nt * 64, kt * 128, p.in[I_QAG], ldsf);
    } else if (it < E_KVUP) {
      const int j = it - E_QUP;
      const int nt = j % 16, second = j / 16;
      transpose_item(p.in[I_WKVUP], 1024, nt * 64, 64, (bfraw*)(p.ws + (second ? WS_WKVUP2 : WS_WKVUP)), 128, nt * 64, 0, second ? nullptr : p.in[I_KVAG], ldsf);
    }
  }
  asm volatile("" :: "v"(sink_v));
}

__device__ __forceinline__ void kmax_item(const Params& p, int j, float* red  ) {
  const int tid = phase_tid(), lane = tid & 63, wave = tid >> 6;
  float* km = (float*)(p.ws + WS_KMAX);
  float v = 0.f;
  int slot = 0;
  if (j < 24) {
    const float* src; int grp;
    if (j < 16) { src = p.in[I_CNAK]; grp = j; slot = 8 + j; }
    else if (j < 20) { src = p.in[I_CGQK]; grp = j - 16; slot = 24 + (j - 16); }
    else { src = p.in[I_CSWK]; grp = j - 20; slot = 28 + (j - 20); }
    const int key = tid >> 1, half = tid & 1;
    const float* kp = src + ((size_t)grp * 256 + key) * 64 + half * 32;
    float ss = 0.f;
#pragma unroll
    for (int i = 0; i < 8; ++i) { const f32x4 x = *(const f32x4*)(kp + i * 4); ss += x[0] * x[0] + x[1] * x[1] + x[2] * x[2] + x[3] * x[3]; }
    ss += __shfl_xor(ss, 1);
    v = ss;
  }
  for (int rep = 0; rep < (j < 24 ? 1 : 5); ++rep) {
    if (j >= 24) {
      v = 0.f;
      if (rep == 0) { if (tid < 64) v = fabsf(p.in[I_NAKG][tid]); slot = 0; }
      else if (rep == 1) { if (tid < 96) v = fabsf(p.in[I_MKG][tid]); slot = 1; }
      else if (rep == 2) { if (tid < 64) v = fabsf(p.in[I_GKG][tid]); slot = 2; }
      else if (rep == 3) { if (tid < 64) v = fabsf(p.in[I_SKG][tid]); slot = 3; }
      else { for (int i = tid; i < 8 * 15 * 31; i += NT) v = fmaxf(v, fabsf(p.in[I_RPB][i])); slot = 4; }
    }
#pragma unroll
    for (int o = 1; o < 64; o <<= 1) v = fmaxf(v, __shfl_xor(v, o));
    __syncthreads();
    if (lane == 0) red[wave] = v;
    __syncthreads();
    if (tid == 0) {
      float m = red[0];
      for (int w = 1; w < 8; ++w) m = fmaxf(m, red[w]);
      float out;
      if (j < 24) out = sqrtf(m) * 1.01f;
      else if (rep == 1) out = 9.797958971f * m * 1.01f;
      else if (rep == 4) out = m;
      else out = 8.f * m * 1.01f;
      km[slot] = out;
    }
  }
}

__device__ __forceinline__ void prep_misc_item(const Params& p, int jm, float* ldsf) {
  if (jm >= 196) { kmax_item(p, jm - 196, ldsf + 4096); return; }
  const int tid = phase_tid();
  bfraw* AX = (bfraw*)(p.ws + WS_AX);
  bfraw* VT = (bfraw*)(p.ws + WS_VT);
  if (jm < 48) {
    const int j = jm;
      float* cosA = (float*)(p.ws + WS_COSA); float* sinA = (float*)(p.ws + WS_SINA);
      float* cosH = (float*)(p.ws + WS_COSH); float* sinH = (float*)(p.ws + WS_SINH);
      for (int e = j * 1024 + tid; e < (j + 1) * 1024; e += NT) {
        if (e < 16384) {
          const int pos = e >> 4, i = e & 15;
          const float inv = powf(10000.f, -(float)(i & 7) / 8.f);
          const float ang = (float)((i < 8) ? (pos >> 6) : (pos & 63)) * inv;
          cosA[e] = cosf(ang); sinA[e] = sinf(ang);
        } else {
          const int e2 = e - 16384;
          const int pos = e2 >> 5, i = e2 & 31;
          const float inv = powf(10000.f, -(float)(i & 15) / 16.f);
          const float ang = (float)((i < 16) ? (pos >> 6) : (pos & 63)) * inv;
          cosH[e2] = cosf(ang); sinH[e2] = sinf(ang);
        }
      }
  } else {
    const int j = jm - 48;
      for (int q = 0; q < 8; ++q) {
        if (j < 16) {
          const int e = j * 4096 + q * NT + tid;
          const int b = e >> 15, s = (e >> 7) & 255, d = e & 127;
          AX[(size_t)(T_ALL + b * 256 + s) * LD0 + C0_CKV + d] = f2bf(p.in[I_CCKV][e]);
        } else if (j < 20) {
          const int e = (j - 16) * 4096 + q * NT + tid;
          const int b = e >> 13, s = (e >> 5) & 255, d = e & 31;
          ((float*)(p.ws + WS_KROPE))[(size_t)(T_ALL + b * 256 + s) * 32 + d] = p.in[I_CKROPE][e];
        } else if (j < 84) {
          const int e = (j - 20) * 4096 + q * NT + tid;
          const int b = e >> 17, h = (e >> 14) & 7, s = (e >> 6) & 255, d = e & 63;
          ((bfraw*)(p.ws + WS_KH))[((size_t)h * TP + T_ALL + b * 256 + s) * 64 + d] = f2bf(p.in[I_CNAK][e]);
        } else {
          const int e = (j - 84) * 4096 + q * NT + tid;
          const int b = e >> 17, h = (e >> 14) & 7, s = (e >> 6) & 255, d = e & 63;
          VT[vc_off(h, T_ALL + b * 256 + s, d)] = f2bf(p.in[I_CNAV][e]);
        }
      }
  }
}

__device__ __forceinline__ void prep1_item(const Params& p, int j);
__device__ __forceinline__ void prep_deferred(const Params& p, float* ldsf) {
  constexpr int NUNITS = 160, NITEMS = 448 + 64 + 96;
  const int G = (int)gridDim.x;
  int first, stride;
  if (G > NUNITS) { if ((int)blockIdx.x < NUNITS) return; first = (int)blockIdx.x - NUNITS; stride = G - NUNITS; }
  else { first = (int)blockIdx.x; stride = G; }
  for (int j = first; j < NITEMS; j += stride) {
    if (j < 320) {
      const int nt = j % 40, kt = j / 40;
      transpose_item(p.in[I_WINO], 2560, 0, 64, (bfraw*)(p.ws + WS_WIN1), 1024, nt * 64, kt * 128, nullptr, ldsf, (nt * 64) >> 8, 0);
    } else if (j < 448) {
      const int j2 = j - 320;
      const int nt = j2 % 16, kt = j2 / 16;
      transpose_item(p.in[I_WOUTO], 1024, nt * 64, 64, (bfraw*)(p.ws + WS_WOUT1), 1024, nt * 64, kt * 128, nullptr, ldsf);
    } else {
      if (j < 512) prep1_item(p, j - 448);
      else mod_item(p, 1, (j - 512) * 32, ldsf);
    }
  }
}

__device__ __forceinline__ void prep1_item(const Params& p, int j) {
  bfraw* AX = (bfraw*)(p.ws + WS_AX);
  bfraw* VT = (bfraw*)(p.ws + WS_VT);
  const int tid = phase_tid();
  const int which = j >> 4;
  for (int q = 0; q < 8; ++q) {
    const int e = (j & 15) * 4096 + q * NT + tid;
    const int b = e >> 15, kv = (e >> 14) & 1, s = (e >> 6) & 255, d = e & 63;
    const size_t tok = T_ALL + b * 256 + s;
    if (which == 0) ((bfraw*)(p.ws + WS_KH))[((size_t)kv * TP + tok) * 64 + d] = f2bf(p.in[I_CGQK][e]);
    else if (which == 1) VT[vc_off(kv, (int)tok, d)] = f2bf(p.in[I_CGQV][e]);
    else if (which == 2) ((bfraw*)(p.ws + WS_KH))[((size_t)(2 + kv) * TP + tok) * 64 + d] = f2bf(p.in[I_CSWK][e]);
    else VT[vc_off(2 + kv, (int)tok, d)] = f2bf(p.in[I_CSWV][e]);
  }
}

__device__ __forceinline__ void phase_modulate(const Params& p, int layer, unsigned char* ldsraw) {
  float* gm = (float*)ldsraw;
  float* sh = gm + 1024;
  const int tid = phase_tid(), lane = tid & 63, wave = tid >> 6;
  bfraw* H = (bfraw*)(p.ws + WS_HY);
  const bfraw* X1 = (const bfraw*)(p.ws + WS_X1);
  const int nitems = T_ALL / 32 + (layer == 0 ? 196 + 25 : 0);
  for (int it = blockIdx.x; it < nitems; it += gridDim.x) {
    if (it >= T_ALL / 32) { prep_misc_item(p, it - T_ALL / 32, (float*)ldsraw); continue; }
    const int tok0 = it * 32;
    const int cnd = (tok0 < T_CTX) ? 0 : 1 + ((tok0 - T_CTX) >> 10);
    const float* mf = (const float*)(p.ws + WS_MODF) + (layer * 3 + cnd) * 3072;
    __syncthreads();
    for (int i = tid; i < 1024; i += NT) {
      gm[i] = p.in[I_NORMG][layer * 1024 + i] * (1.f + mf[1024 + i]);
      sh[i] = mf[i];
    }
    __syncthreads();
    f32x4 v[4][4];
#pragma unroll
    for (int rr = 0; rr < 4; ++rr) {
      const int tok = tok0 + wave * 4 + rr;
      if (layer == 0) {
        const float* xr = (tok < T_CTX) ? p.in[I_XP] + (size_t)tok * 1024 : p.in[I_XS] + (size_t)(tok - T_CTX) * 1024;
#pragma unroll
        for (int i = 0; i < 4; ++i) v[rr][i] = *(const f32x4*)(xr + i * 256 + lane * 4);
      } else {
#pragma unroll
        for (int i = 0; i < 4; ++i) v[rr][i] = ld_bf16x4(X1 + (size_t)tok * 1024 + i * 256 + lane * 4);
      }
    }
#pragma unroll
    for (int rr = 0; rr < 4; ++rr) {
      const int tok = tok0 + wave * 4 + rr;
      float ss = 0.f;
#pragma unroll
      for (int i = 0; i < 4; ++i)
#pragma unroll
        for (int r = 0; r < 4; ++r) ss += v[rr][i][r] * v[rr][i][r];
#pragma unroll
      for (int o = 1; o < 64; o <<= 1) ss += __shfl_xor(ss, o);
      const float rs = rsqrtf(ss * (1.f / 1024.f) + EPSF);
#pragma unroll
      for (int i = 0; i < 4; ++i) {
        const int c = i * 256 + lane * 4;
        f32x4 o;
#pragma unroll
        for (int r = 0; r < 4; ++r) o[r] = v[rr][i][r] * rs * gm[c + r] + sh[c + r];
        *(uint2*)(H + (size_t)tok * 1024 + c) = pack4(o);
      }
    }
  }
}

namespace pg8 {
#define PG8_LAS __attribute__((address_space(3)))
constexpr int BM = 256, BK = 64, HALF = 128, HTB = HALF * BK * 2, STAGE_BYTES = 8 * HTB, NXCD = 8, WGM = 8;
__device__ __forceinline__ int lds_byte(int r, int c) { const int st = (r >> 4) * 2 + (c >> 5), rr = r & 15, cc = c & 31, ob = rr * 64 + cc * 2; return st * 1024 + (ob ^ (((ob >> 9) & 1) << 5)); }
__device__ __forceinline__ void stage_rc(int b, int& R, int& C) { const int st = b / 1024, sb = b % 1024, swz = sb ^ (((sb >> 9) & 1) << 5); R = (st >> 1) * 16 + swz / 64; C = (st & 1) * 32 + (swz % 64) / 2; }
struct Unit { int pm, pn; };
struct Gemm { const bfraw* A; const bfraw* Bt; int M, N, K; };
struct StaticOrder {
  int nM, nN, nwg, G, c;
  __device__ void init(int M, int N, int G_, int c_) { nM = M / BM; nN = N / BM; nwg = nM * nN; G = G_; c = c_; }
  __device__ bool next(int i, Unit& u) const {
    const long L = (long)i * G + c; if (L >= nwg) return false;
    int wgid = (int)L; { const int q = nwg / NXCD, r = nwg % NXCD, xcd = wgid % NXCD, off = wgid / NXCD; wgid = (xcd < r ? xcd * (q + 1) : r * (q + 1) + (xcd - r) * q) + off; }
    const int nig = WGM * nN, gid = wgid / nig, fm = gid * WGM, gsz = (nM - fm) < WGM ? (nM - fm) : WGM;
    u.pm = fm + ((wgid % nig) % gsz); u.pn = (wgid % nig) / gsz; return true;
  }
};
template <class Epi>
__device__ __forceinline__ void gemm_phase(PG8_LAS unsigned char* lds, const Gemm g, const StaticOrder& S, const Epi& E) {
  const int tid = phase_tid(), wid = __builtin_amdgcn_readfirstlane(tid >> 6), lane = tid & 63, wr = wid >> 2, wc = wid & 3, fr = lane & 15, fq = lane >> 4;
  const int K = g.K, nt = K / BK;
  unsigned voffA;
  { int R, C; stage_rc(tid * 16, R, C); voffA = (unsigned)(R * K + C) * 2u; }
  const size_t rstep64 = (size_t)64 * K * 2;
  const size_t kstep = (size_t)(BK * 2);
  const size_t hstep = (size_t)HALF * K * 2;
  const size_t tstep = 2 * hstep;
  const unsigned ldsw = (unsigned)wid * 1024u;
  const int aoff = lds_byte(wr * 64 + fr, fq * 8), boff = lds_byte(wc * 32 + fr, fq * 8);
#define PG8_SA(b, h) (((b) * 2 + (h)) * HTB)
#define PG8_SB(b, h) ((4 + (b) * 2 + (h)) * HTB)
#define PG8_STAGE(bufoff, gbase, voff) do { _Pragma("unroll") for (int _i = 0; _i < 2; ++_i) \
    __builtin_amdgcn_global_load_lds((const unsigned*)((const char*)(gbase) + _i * rstep64 + (voff)), (PG8_LAS unsigned*)(lds + (bufoff) + ldsw + _i * 8192), 16, 0, 0); } while (0)
#define PG8_LDA(dst, b, h) do { _Pragma("unroll") for (int m = 0; m < 4; ++m) _Pragma("unroll") for (int k = 0; k < 2; ++k) dst[m][k] = *(const PG8_LAS bf16x8*)(lds + PG8_SA(b, h) + aoff + m * 2048 + k * 1024); } while (0)
#define PG8_LDB(dst, b, h) do { _Pragma("unroll") for (int n = 0; n < 2; ++n) _Pragma("unroll") for (int k = 0; k < 2; ++k) dst[n][k] = *(const PG8_LAS bf16x8*)(lds + PG8_SB(b, h) + boff + n * 2048 + k * 1024); } while (0)
#define PG8_MMA(ai, bj, At, Bt) do { __builtin_amdgcn_s_setprio(1); _Pragma("unroll") for (int m = 0; m < 4; ++m) _Pragma("unroll") for (int n = 0; n < 2; ++n) _Pragma("unroll") for (int k = 0; k < 2; ++k) \
    acc[ai][bj][m][n] = __builtin_amdgcn_mfma_f32_16x16x32_bf16(Bt[n][k], At[m][k], acc[ai][bj][m][n], 0, 0, 0); __builtin_amdgcn_s_setprio(0); } while (0)
#define PG8_WAIT_V(n) asm volatile("s_waitcnt vmcnt(" #n ")" ::: "memory")
#define PG8_WAIT_L(n) asm volatile("s_waitcnt lgkmcnt(" #n ")" ::: "memory")
#define PG8_BAR __builtin_amdgcn_s_barrier()
#define PG8_SCHED __builtin_amdgcn_sched_barrier(0)
  Unit cur, nxt; int ui = 0;
  if (!S.next(0, cur)) return;
  f32x4 acc[2][2][4][2];
#pragma unroll
  for (int a = 0; a < 2; ++a)
#pragma unroll
    for (int b = 0; b < 2; ++b)
#pragma unroll
      for (int m = 0; m < 4; ++m)
#pragma unroll
        for (int n = 0; n < 2; ++n) acc[a][b][m][n] = (f32x4){0.f, 0.f, 0.f, 0.f};
  bf16x8 At[4][2], B0[2][2], B1[2][2];
  const char* cA = (const char*)g.A + (size_t)cur.pm * tstep; const char* cB = (const char*)g.Bt + (size_t)cur.pn * tstep;
  PG8_STAGE(PG8_SB(0, 0), cB, voffA); PG8_STAGE(PG8_SA(0, 0), cA, voffA); PG8_STAGE(PG8_SB(0, 1), cB + hstep, voffA); PG8_STAGE(PG8_SA(0, 1), cA + hstep, voffA);
  if (wr == 1) PG8_BAR;
  PG8_WAIT_V(4); PG8_BAR;
  PG8_STAGE(PG8_SB(1, 0), cB + kstep, voffA); PG8_STAGE(PG8_SA(1, 0), cA + kstep, voffA); PG8_STAGE(PG8_SB(1, 1), cB + hstep + kstep, voffA);
  PG8_WAIT_V(6); PG8_BAR;
  for (;;) {
    const bool has_next = S.next(ui + 1, nxt);
    const char* nA = has_next ? (const char*)g.A + (size_t)nxt.pm * tstep : cA; const char* nB = has_next ? (const char*)g.Bt + (size_t)nxt.pn * tstep : cB;
    for (int t = 0; t < nt; t += 2) {
      const bool last = (t == nt - 2);
      const char* a1 = cA + (size_t)(t + 1) * kstep;
      const char* a2 = last ? nA : cA + (size_t)(t + 2) * kstep; const char* b2 = last ? nB : cB + (size_t)(t + 2) * kstep;
      const char* a3 = a2 + kstep; const char* b3 = b2 + kstep;
      PG8_LDB(B0, 0, 0); PG8_SCHED; PG8_LDA(At, 0, 0); PG8_STAGE(PG8_SA(1, 1), a1 + hstep, voffA);
      PG8_WAIT_L(8); PG8_BAR; PG8_WAIT_L(0); PG8_MMA(0, 0, At, B0); PG8_BAR; PG8_SCHED;
      PG8_LDB(B1, 0, 1); PG8_STAGE(PG8_SB(0, 0), b2, voffA);
      PG8_BAR; PG8_WAIT_L(0); PG8_MMA(0, 1, At, B1); PG8_BAR;
      PG8_LDA(At, 0, 1); PG8_STAGE(PG8_SA(0, 0), a2, voffA);
      PG8_BAR; PG8_WAIT_L(0); PG8_MMA(1, 0, At, B0); PG8_BAR; PG8_SCHED;
      PG8_STAGE(PG8_SB(0, 1), b2 + hstep, voffA);
      PG8_WAIT_V(6); PG8_BAR; PG8_MMA(1, 1, At, B1); PG8_BAR;
      PG8_LDB(B0, 1, 0); PG8_SCHED; PG8_LDA(At, 1, 0); PG8_STAGE(PG8_SA(0, 1), a2 + hstep, voffA);
      PG8_WAIT_L(8); PG8_BAR; PG8_WAIT_L(0); PG8_MMA(0, 0, At, B0); PG8_BAR; PG8_SCHED;
      PG8_LDB(B1, 1, 1); PG8_STAGE(PG8_SB(1, 0), b3, voffA);
      PG8_BAR; PG8_WAIT_L(0); PG8_MMA(0, 1, At, B1); PG8_BAR;
      PG8_LDA(At, 1, 1); PG8_STAGE(PG8_SA(1, 0), a3, voffA);
      PG8_BAR; PG8_WAIT_L(0); PG8_MMA(1, 0, At, B0); PG8_BAR; PG8_SCHED;
      PG8_STAGE(PG8_SB(1, 1), b3 + hstep, voffA);
      PG8_WAIT_V(6); PG8_BAR; PG8_MMA(1, 1, At, B1); PG8_BAR;
    }
    E(acc, cur, wr, wc, fr, fq);
    if (!has_next) break;
#pragma unroll
    for (int a = 0; a < 2; ++a)
#pragma unroll
      for (int b = 0; b < 2; ++b)
#pragma unroll
        for (int m = 0; m < 4; ++m)
#pragma unroll
          for (int n = 0; n < 2; ++n) acc[a][b][m][n] = (f32x4){0.f, 0.f, 0.f, 0.f};
    cur = nxt; cA = nA; cB = nB; ++ui;
  }
  PG8_WAIT_V(0);
  if (wr == 0) PG8_BAR;
  PG8_BAR;
#undef PG8_SA
#undef PG8_SB
#undef PG8_STAGE
#undef PG8_LDA
#undef PG8_LDB
#undef PG8_MMA
#undef PG8_WAIT_V
#undef PG8_WAIT_L
#undef PG8_BAR
#undef PG8_SCHED
}
}

typedef f32x4 SubAcc[4][2];
__device__ __forceinline__ float red16(float v) { v += __shfl_xor(v, 1); v += __shfl_xor(v, 2); v += __shfl_xor(v, 4); v += __shfl_xor(v, 8); return v; }
__device__ __forceinline__ void sub_head_norm(SubAcc& a, const float* __restrict__ g, float post, int fr) {
  float gv[4];
#pragma unroll
  for (int m = 0; m < 4; ++m) gv[m] = g[m * 16 + fr];
#pragma unroll
  for (int n = 0; n < 2; ++n) {
    f32x4 ss = a[0][n] * a[0][n] + a[1][n] * a[1][n] + a[2][n] * a[2][n] + a[3][n] * a[3][n];
    f32x4 rs;
#pragma unroll
    for (int j = 0; j < 4; ++j) rs[j] = rsqrtf(red16(ss[j]) * (1.f / 64.f) + EPSF) * post;
#pragma unroll
    for (int m = 0; m < 4; ++m) a[m][n] = a[m][n] * rs * gv[m];
  }
}
__device__ __forceinline__ void sub_rope64(SubAcc& a, const float* __restrict__ cosH, const float* __restrict__ sinH, int tbase, int fr, int fq) {
#pragma unroll
  for (int n = 0; n < 2; ++n) {
#pragma unroll
    for (int j = 0; j < 4; ++j) {
      const unsigned pos = (unsigned)(((tbase + n * 16 + fq * 4 + j - T_CTX) & 1023) * 32 + fr);
#pragma unroll
      for (int m = 0; m < 2; ++m) {
        const float c = cosH[pos + m * 16], s = sinH[pos + m * 16];
        const float x1 = a[m][n][j], x2 = a[m + 2][n][j];
        a[m][n][j] = x1 * c - x2 * s;
        a[m + 2][n][j] = x1 * s + x2 * c;
      }
      __builtin_amdgcn_sched_barrier(0);
    }
  }
}
__device__ __forceinline__ void sub_store_tok(const SubAcc& a, bfraw* __restrict__ dst, int ld, int col0, int tbase, int fr, int fq) {
#pragma unroll
  for (int n = 0; n < 2; ++n) {
#pragma unroll
    for (int j = 0; j < 4; ++j) {
      const unsigned off = (unsigned)((tbase + n * 16 + fq * 4 + j) * ld + col0 + fr);
#pragma unroll
      for (int m = 0; m < 4; ++m) dst[off + m * 16] = f2bf(a[m][n][j]);
      __builtin_amdgcn_sched_barrier(0);
    }
  }
}
__device__ __forceinline__ void sub_store_vt(const SubAcc& a, bfraw* __restrict__ vt, int row0, int tbase, int fr, int fq) {
#pragma unroll
  for (int m = 0; m < 4; ++m)
#pragma unroll
    for (int n = 0; n < 2; ++n) *(uint2*)(vt + (unsigned)((row0 + m * 16 + fr) * TP + tbase + n * 16 + fq * 4)) = pack4(a[m][n]);
}
__device__ __forceinline__ void sub_store_cache(const SubAcc& a, float* __restrict__ o, int nh, int hh, int tbase, int fr, int fq) {
#pragma unroll
  for (int n = 0; n < 2; ++n) {
#pragma unroll
    for (int j = 0; j < 4; ++j) {
      const int tok = tbase + n * 16 + fq * 4 + j;
      const unsigned off = (unsigned)((((tok >> 8) * nh + hh) * 256 + (tok & 255)) * 64 + fr);
#pragma unroll
      for (int m = 0; m < 4; ++m) o[off + m * 16] = a[m][n][j];
      __builtin_amdgcn_sched_barrier(0);
    }
  }
}
__device__ __forceinline__ void sub_silu(SubAcc& a) {
#pragma unroll
  for (int m = 0; m < 4; ++m)
#pragma unroll
    for (int n = 0; n < 2; ++n)
#pragma unroll
      for (int j = 0; j < 4; ++j) a[m][n][j] = silu_f(a[m][n][j]);
}

struct Row4 { f32x4 a[2][2]; };
__device__ __forceinline__ float row_ss(const Row4& r) {
  f32x4 s = r.a[0][0] * r.a[0][0] + r.a[0][1] * r.a[0][1] + r.a[1][0] * r.a[1][0] + r.a[1][1] * r.a[1][1];
  return quad_sum(s[0] + s[1] + s[2] + s[3]);
}
__device__ __forceinline__ void row_norm(Row4& r, const f32x4 (&gv)[2][2], float post) {
  const float rs = rsqrtf(row_ss(r) * (1.f / 64.f) + EPSF) * post;
#pragma unroll
  for (int bj = 0; bj < 2; ++bj)
#pragma unroll
    for (int n = 0; n < 2; ++n) r.a[bj][n] = r.a[bj][n] * rs * gv[bj][n];
}
__device__ __forceinline__ void row_rope(Row4& r, const float* __restrict__ cosH, const float* __restrict__ sinH, int tok, int fq) {
  const int pos = (tok - T_CTX) & 1023;
#pragma unroll
  for (int n = 0; n < 2; ++n) {
    const f32x4 c = *(const f32x4*)(cosH + pos * 32 + n * 16 + fq * 4);
    const f32x4 s = *(const f32x4*)(sinH + pos * 32 + n * 16 + fq * 4);
    const f32x4 x1 = r.a[0][n], x2 = r.a[1][n];
    r.a[0][n] = x1 * c - x2 * s;
    r.a[1][n] = x1 * s + x2 * c;
  }
}
__device__ __forceinline__ void row_store_bf16(const Row4& r, bfraw* __restrict__ p  ) {
#pragma unroll
  for (int bj = 0; bj < 2; ++bj)
#pragma unroll
    for (int n = 0; n < 2; ++n) *(uint2*)(p + bj * 32 + n * 16) = pack4(r.a[bj][n]);
}
__device__ __forceinline__ void row_store_f32(const Row4& r, float* __restrict__ p) {
#pragma unroll
  for (int bj = 0; bj < 2; ++bj)
#pragma unroll
    for (int n = 0; n < 2; ++n) st_nt4(p + bj * 32 + n * 16, r.a[bj][n]);
}
__device__ __forceinline__ void row_store_f32_keep(const Row4& r, float* __restrict__ p) {
#pragma unroll
  for (int bj = 0; bj < 2; ++bj)
#pragma unroll
    for (int n = 0; n < 2; ++n) *(f32x4*)(p + bj * 32 + n * 16) = r.a[bj][n];
}
__device__ __forceinline__ void row_store_vt(const Row4& r, bfraw* __restrict__ vt  ) {
#pragma unroll
  for (int bj = 0; bj < 2; ++bj)
#pragma unroll
    for (int n = 0; n < 2; ++n)
#pragma unroll
      for (int j = 0; j < 4; ++j) vt[(bj * 32 + n * 16 + j) * 64] = f2bf(r.a[bj][n][j]);
}
__device__ __forceinline__ void row_silu(Row4& r) {
#pragma unroll
  for (int bj = 0; bj < 2; ++bj)
#pragma unroll
    for (int n = 0; n < 2; ++n)
#pragma unroll
      for (int j = 0; j < 4; ++j) r.a[bj][n][j] = silu_f(r.a[bj][n][j]);
}
#define ROW_GET(r, acc, ai, m) do { (r).a[0][0] = acc[ai][0][m][0]; (r).a[0][1] = acc[ai][0][m][1]; (r).a[1][0] = acc[ai][1][m][0]; (r).a[1][1] = acc[ai][1][m][1]; } while (0)

struct EpiIn0 {
  const Params* pp;
  __device__ __forceinline__ void operator()(f32x4 (&acc)[2][2][4][2], const pg8::Unit& u, int wr, int wc, int fr, int fq) const {
    const Params& p = *pp;
    bfraw* AX = (bfraw*)(p.ws + WS_AX);
    bfraw* VT = (bfraw*)(p.ws + WS_VT);
    const int fbase = (u.pn * 4 + wc) * 64;
    const int tok_t = u.pm * 256;
    const bool ctx = tok_t < T_CTX;
    f32x4 gv[2][2];
    const float* g = (fbase < C0_KB) ? p.in[I_NAQG] : p.in[I_NAKG];
#pragma unroll
    for (int bj = 0; bj < 2; ++bj)
#pragma unroll
      for (int n = 0; n < 2; ++n) gv[bj][n] = *(const f32x4*)(g + bj * 32 + n * 16 + fq * 4);
#pragma unroll
    for (int ai = 0; ai < 2; ++ai)
#pragma unroll
      for (int m = 0; m < 4; ++m) {
        const int tok = tok_t + ai * 128 + wr * 64 + m * 16 + fr;
        Row4 r; ROW_GET(r, acc, ai, m);
        bfraw* axp = AX + (size_t)tok * LD0 + fbase + fq * 4;
        if (fbase < C0_KB) {
          row_norm(r, gv, 0.125f * LOG2E);
          row_store_bf16(r, axp);
        } else if (fbase < C0_VB) {
          row_norm(r, gv, 1.f);
          row_store_bf16(r, (bfraw*)(p.ws + WS_KH) + ((size_t)((fbase - C0_KB) >> 6) * TP + tok) * 64 + fq * 4);
          if (ctx) row_store_f32(r, p.out + O_NAK + ((size_t)((tok >> 8) * 8 + ((fbase - C0_KB) >> 6)) * 256 + (tok & 255)) * 64 + fq * 4);
        } else if (fbase < C0_GA) {
          row_store_vt(r, VT + vc_off((fbase - C0_VB) >> 6, tok, fq * 4));
          if (ctx) row_store_f32(r, p.out + O_NAV + ((size_t)((tok >> 8) * 8 + ((fbase - C0_VB) >> 6)) * 256 + (tok & 255)) * 64 + fq * 4);
        } else if (fbase < C0_QLAT) {
          row_silu(r);
          row_store_bf16(r, axp);
        } else if (fbase < C0_CKV) {
          const float ss = row_ss(r);
          if (fq == 0) ((float*)(p.ws + WS_QSS))[(size_t)tok * 4 + ((fbase - C0_QLAT) >> 6)] = ss;
          row_store_bf16(r, axp);
        } else if (fbase < C0_KROPE) {
          const float ss = row_ss(r);
          if (fq == 0) ((float*)(p.ws + WS_CKSS))[(size_t)tok * 2 + ((fbase - C0_CKV) >> 6)] = ss;
          row_store_bf16(r, axp);
          if (ctx) row_store_f32_keep(r, p.out + O_CKV + (size_t)tok * 128 + (fbase - C0_CKV) + fq * 4);
        } else if (fbase == C0_KROPE) {
          float* kr = (float*)(p.ws + WS_KROPE) + (size_t)tok * 32 + fq * 4;
          *(f32x4*)(kr) = r.a[0][0]; *(f32x4*)(kr + 16) = r.a[0][1];
          if (ctx) { float* o = p.out + O_KROPE + (size_t)tok * 32 + fq * 4; st_nt4(o, r.a[0][0]); st_nt4(o + 16, r.a[0][1]); }
        }
        __builtin_amdgcn_sched_barrier(0);
      }
  }
};
__device__ __forceinline__ void phase_gemm_in0(const Params& p, unsigned char* ldsraw) {
  pg8::Gemm g{(const bfraw*)(p.ws + WS_HY), (const bfraw*)(p.ws + WS_WIN0), T_ALL, 3072, 1024};
  pg8::StaticOrder S; S.init(T_ALL, 3072, (int)gridDim.x, (int)blockIdx.x);
  EpiIn0 E{&p};
  __syncthreads();
  pg8::gemm_phase((PG8_LAS unsigned char*)ldsraw, g, S, E);
}

struct EpiIn1 {
  const Params* pp;
  __device__ __forceinline__ void operator()(f32x4 (&acc)[2][2][4][2], const pg8::Unit& u, int wr, int wc, int fr, int fq) const {
    const Params& p = *pp;
    bfraw* AX = (bfraw*)(p.ws + WS_AX);
    bfraw* VT = (bfraw*)(p.ws + WS_VT);
    const float* cosH = (const float*)(p.ws + WS_COSH);
    const float* sinH = (const float*)(p.ws + WS_SINH);
    const int fbase = (u.pn * 4 + wc) * 64;
    const int tok_t = u.pm * 256;
    const bool ctx = tok_t < T_CTX;
    const bool isq = fbase < C1_KC || (fbase >= C1_QD && fbase < C1_KD);
    const bool isk = (fbase >= C1_KC && fbase < C1_VC) || (fbase >= C1_KD && fbase < C1_VD);
    const bool isv = (fbase >= C1_VC && fbase < C1_GC) || (fbase >= C1_VD && fbase < C1_GD);
    const bool isC = fbase < C1_QD;
    const float* g = isq ? (isC ? p.in[I_GQG] : p.in[I_SQG]) : (isC ? p.in[I_GKG] : p.in[I_SKG]);
    f32x4 gv[2][2];
#pragma unroll
    for (int bj = 0; bj < 2; ++bj)
#pragma unroll
      for (int n = 0; n < 2; ++n) gv[bj][n] = *(const f32x4*)(g + bj * 32 + n * 16 + fq * 4);
#pragma unroll
    for (int ai = 0; ai < 2; ++ai)
#pragma unroll
      for (int m = 0; m < 4; ++m) {
        const int tok = tok_t + ai * 128 + wr * 64 + m * 16 + fr;
        Row4 r; ROW_GET(r, acc, ai, m);
        bfraw* axp = AX + (size_t)tok * LD1 + fbase + fq * 4;
        if (isq) {
          row_norm(r, gv, 0.125f * LOG2E);
          if (!ctx) row_rope(r, cosH, sinH, tok, fq);
          row_store_bf16(r, axp);
        } else if (isk) {
          row_norm(r, gv, 1.f);
          if (ctx) row_store_f32(r, p.out + (isC ? O_GQK : O_SWK) + ((size_t)((tok >> 8) * 2 + ((fbase - (isC ? C1_KC : C1_KD)) >> 6)) * 256 + (tok & 255)) * 64 + fq * 4);
          else row_rope(r, cosH, sinH, tok, fq);
          row_store_bf16(r, (bfraw*)(p.ws + WS_KH) + ((size_t)(isC ? ((fbase - C1_KC) >> 6) : 2 + ((fbase - C1_KD) >> 6)) * TP + tok) * 64 + fq * 4);
        } else if (isv) {
          const int vh = isC ? ((fbase - C1_VC) >> 6) : 2 + ((fbase - C1_VD) >> 6);
          row_store_vt(r, VT + vc_off(vh, tok, fq * 4));
          if (ctx) row_store_f32(r, p.out + (isC ? O_GQV : O_SWV) + ((size_t)((tok >> 8) * 2 + ((fbase - (isC ? C1_VC : C1_VD)) >> 6)) * 256 + (tok & 255)) * 64 + fq * 4);
        } else {
          row_silu(r);
          row_store_bf16(r, axp);
        }
        __builtin_amdgcn_sched_barrier(0);
      }
  }
};
__device__ __forceinline__ void phase_gemm_in1(const Params& p, unsigned char* ldsraw) {
  pg8::Gemm g{(const bfraw*)(p.ws + WS_HY), (const bfraw*)(p.ws + WS_WIN1), T_ALL, 2560, 1024};
  pg8::StaticOrder S; S.init(T_ALL, 2560, (int)gridDim.x, (int)blockIdx.x);
  EpiIn1 E{&p};
  __syncthreads();
  pg8::gemm_phase((PG8_LAS unsigned char*)ldsraw, g, S, E);
}

struct EpiOut {
  const Params* pp; int layer;
  __device__ __forceinline__ void operator()(f32x4 (&acc)[2][2][4][2], const pg8::Unit& u, int wr, int wc, int fr, int fq) const {
    const Params& p = *pp;
    bfraw* X1 = (bfraw*)(p.ws + WS_X1);
    const int tok_t = u.pm * 256;
    const int cnd = (tok_t < T_CTX) ? 0 : 1 + ((tok_t - T_CTX) >> 10);
    const float* gate = (const float*)(p.ws + WS_MODF) + (layer * 3 + cnd) * 3072 + 2048;
    const int col0 = u.pn * 256 + wc * 32 + fq * 4;
    f32x4 gv[2][2];
#pragma unroll
    for (int bj = 0; bj < 2; ++bj)
#pragma unroll
      for (int n = 0; n < 2; ++n) gv[bj][n] = *(const f32x4*)(gate + col0 + bj * 128 + n * 16);
#pragma unroll
    for (int ai = 0; ai < 2; ++ai)
#pragma unroll
      for (int m = 0; m < 4; ++m) {
        const int tok = tok_t + ai * 128 + wr * 64 + m * 16 + fr;
        const float* xr = (tok < T_CTX) ? p.in[I_XP] + (size_t)tok * 1024 : p.in[I_XS] + (size_t)(tok - T_CTX) * 1024;
        bfraw* x1r = X1 + (size_t)tok * 1024;
        float* orow = p.out + (size_t)tok * 1024;
#pragma unroll
        for (int bj = 0; bj < 2; ++bj)
#pragma unroll
          for (int n = 0; n < 2; ++n) {
            const int c = col0 + bj * 128 + n * 16;
            const f32x4 xv = (layer == 0) ? *(const f32x4*)(xr + c) : ld_bf16x4(x1r + c);
            const f32x4 ov = xv + gv[bj][n] * acc[ai][bj][m][n];
            if (layer == 1) st_nt4(orow + c, ov); else *(uint2*)(x1r + c) = pack4(ov);
          }
        __builtin_amdgcn_sched_barrier(0);
      }
  }
};
__device__ __forceinline__ void phase_gemm_out(const Params& p, int layer, unsigned char* ldsraw) {
  pg8::Gemm g{(const bfraw*)(p.ws + WS_HY), (const bfraw*)(p.ws + (layer ? WS_WOUT1 : WS_WOUT0)), T_ALL, 1024, 1024};
  pg8::StaticOrder S; S.init(T_ALL, 1024, (int)gridDim.x, (int)blockIdx.x);
  EpiOut E{&p, layer};
  __syncthreads();
  pg8::gemm_phase((PG8_LAS unsigned char*)ldsraw, g, S, E);
  if (layer == 0) prep_deferred(p, (float*)ldsraw);
}

__device__ __forceinline__ void phase_up0(const Params& p, unsigned char* ldsraw) {
  bfraw* lds = (bfraw*)ldsraw;
  const bfraw* AX = (const bfraw*)(p.ws + WS_AX);
  const float* cosA = (const float*)(p.ws + WS_COSA);
  const float* sinA = (const float*)(p.ws + WS_SINA);
  const int tid = phase_tid(), lane = tid & 63, wave = tid >> 6;
  const int r16 = lane & 15, q4 = lane >> 4;
  constexpr int NQ = 40 * 8, NKV = 42 * 8, NFIN = 128;
  for (int tile = blockIdx.x; tile < NQ + NKV + NFIN; tile += gridDim.x) {
    if (tile >= NQ + NKV) {
      const int j = tile - NQ - NKV;
      const float* ckss = (const float*)(p.ws + WS_CKSS);
      const float* kg = p.in[I_KVAG];
#pragma unroll 4
      for (int q = 0; q < 16; ++q) {
        const int e = q * NT + tid;
        const int tok = j * 64 + (e >> 7), d = e & 127;
        const float rs = rsqrtf((ckss[(size_t)tok * 2] + ckss[(size_t)tok * 2 + 1]) * (1.f / 128.f) + EPSF);
        float* o = p.out + O_CKV + (size_t)tok * 128 + d;
        __builtin_nontemporal_store(*o * rs * kg[d], o);
      }
    } else if (tile < NQ) {
      const int h = tile % 8, mt = tile / 8;
      const int m0 = mt * 256;
      f32x4 acc[6][2];
      gemm_smallk<6, 2, 1, 8, 4>((const bfraw*)(p.ws + WS_WQUP), 256, AX + C0_QLAT, LD0, h * 96, m0, lds, acc);
      const int mw = m0 + wave * 32;
      const float* qss = (const float*)(p.ws + WS_QSS);
      const float* qg = p.in[I_MQG];
      bfraw* QA = (bfraw*)(p.ws + WS_QA);
      f32x4 gv[6];
#pragma unroll
      for (int tn = 0; tn < 6; ++tn) gv[tn] = *(const f32x4*)(qg + tn * 16 + q4 * 4);
      const bool lat = m0 >= T_CTX;
#pragma unroll
      for (int tm = 0; tm < 2; ++tm) {
        const int tok = mw + tm * 16 + r16;
        const f32x4 s4 = *(const f32x4*)(qss + (size_t)tok * 4);
        const float rq = rsqrtf((s4[0] + s4[1] + s4[2] + s4[3]) * (1.f / 256.f) + EPSF);
        float ss = 0.f;
#pragma unroll
        for (int tn = 0; tn < 6; ++tn)
#pragma unroll
          for (int r = 0; r < 4; ++r) { acc[tn][tm][r] *= rq; ss += acc[tn][tm][r] * acc[tn][tm][r]; }
        ss = quad_sum(ss);
        const float rs = rsqrtf(ss * (1.f / 96.f) + EPSF);
#pragma unroll
        for (int tn = 0; tn < 6; ++tn)
#pragma unroll
          for (int r = 0; r < 4; ++r) acc[tn][tm][r] *= rs * gv[tn][r];
        if (lat) {
          const int pos = (tok - T_CTX) & 1023;
          const f32x4 c = *(const f32x4*)(cosA + pos * 16 + q4 * 4);
          const f32x4 s = *(const f32x4*)(sinA + pos * 16 + q4 * 4);
#pragma unroll
          for (int r = 0; r < 4; ++r) {
            const float x1 = acc[4][tm][r], x2 = acc[5][tm][r];
            acc[4][tm][r] = x1 * c[r] - x2 * s[r];
            acc[5][tm][r] = x1 * s[r] + x2 * c[r];
          }
        }
        const float sc = 0.10206207261596577f * LOG2E;
        bfraw* o = QA + (size_t)tok * 768 + h * 96 + q4 * 4;
#pragma unroll
        for (int tn = 0; tn < 6; ++tn) {
          f32x4 v = acc[tn][tm];
#pragma unroll
          for (int r = 0; r < 4; ++r) v[r] *= sc;
          *(uint2*)(o + tn * 16) = pack4(v);
        }
      }
    } else {
      const int t2 = tile - NQ;
      const int h = t2 % 8, mt = t2 / 8;
      const int m0 = mt * 256;
      f32x4 acc[4][4];
      const bool fresh = m0 < T_ALL;
      gemm_smallk<4, 4, 2, 4, 2>((const bfraw*)(p.ws + (fresh ? WS_WKVUP : WS_WKVUP2)), 128, AX + C0_CKV, LD0, h * 128, m0, lds, acc);
      const int wn = wave & 1, wm = wave >> 1;
      const int mw = m0 + wm * 64;
      if (fresh) {
        const float* ckss = (const float*)(p.ws + WS_CKSS);
#pragma unroll
        for (int tm = 0; tm < 4; ++tm) {
          const int tok = mw + tm * 16 + r16;
          const float rsc = rsqrtf((ckss[(size_t)tok * 2] + ckss[(size_t)tok * 2 + 1]) * (1.f / 128.f) + EPSF);
#pragma unroll
          for (int tn = 0; tn < 4; ++tn) acc[tn][tm] = acc[tn][tm] * rsc;
        }
      }
      if (wn == 0) {
        const float* kr = (const float*)(p.ws + WS_KROPE);
        const float* kg = p.in[I_MKG];
        bfraw* KA = (bfraw*)(p.ws + WS_KA);
        const bool lat = (m0 >= T_CTX) && (m0 < T_ALL);
        f32x4 gv[4];
#pragma unroll
        for (int tn = 0; tn < 4; ++tn) gv[tn] = *(const f32x4*)(kg + tn * 16 + q4 * 4);
        const f32x4 g1 = *(const f32x4*)(kg + 64 + q4 * 4), g2 = *(const f32x4*)(kg + 80 + q4 * 4);
#pragma unroll
        for (int tm = 0; tm < 4; ++tm) {
          const int tok = mw + tm * 16 + r16;
          f32x4 k1 = *(const f32x4*)(kr + (size_t)tok * 32 + q4 * 4);
          f32x4 k2 = *(const f32x4*)(kr + (size_t)tok * 32 + 16 + q4 * 4);
          float ss = 0.f;
#pragma unroll
          for (int r = 0; r < 4; ++r) ss += k1[r] * k1[r] + k2[r] * k2[r];
#pragma unroll
          for (int tn = 0; tn < 4; ++tn)
#pragma unroll
            for (int r = 0; r < 4; ++r) ss += acc[tn][tm][r] * acc[tn][tm][r];
          ss = quad_sum(ss);
          const float rs = rsqrtf(ss * (1.f / 96.f) + EPSF);
          bfraw* o = KA + ((size_t)h * TP + tok) * 96 + q4 * 4;
#pragma unroll
          for (int tn = 0; tn < 4; ++tn) {
            f32x4 v;
#pragma unroll
            for (int r = 0; r < 4; ++r) v[r] = acc[tn][tm][r] * rs * gv[tn][r];
            *(uint2*)(o + tn * 16) = pack4(v);
          }
#pragma unroll
          for (int r = 0; r < 4; ++r) { k1[r] *= rs * g1[r]; k2[r] *= rs * g2[r]; }
          if (lat) {
            const int pos = (tok - T_CTX) & 1023;
            const f32x4 c = *(const f32x4*)(cosA + pos * 16 + q4 * 4);
            const f32x4 s = *(const f32x4*)(sinA + pos * 16 + q4 * 4);
#pragma unroll
            for (int r = 0; r < 4; ++r) {
              const float x1 = k1[r], x2 = k2[r];
              k1[r] = x1 * c[r] - x2 * s[r];
              k2[r] = x1 * s[r] + x2 * c[r];
            }
          }
          *(uint2*)(o + 64) = pack4(k1);
          *(uint2*)(o + 80) = pack4(k2);
          __builtin_amdgcn_sched_barrier(0);
        }
      } else {
        {
          bfraw* VT = (bfraw*)(p.ws + WS_VT);
#pragma unroll
          for (int tm = 0; tm < 4; ++tm)
#pragma unroll
            for (int tn = 0; tn < 4; ++tn)
#pragma unroll
              for (int r = 0; r < 4; ++r) VT[vc_off(8 + h, mw + tm * 16 + r16, tn * 16 + q4 * 4 + r)] = f2bf(acc[tn][tm][r]);
        }
      }
    }
  }
}

template <int DKS, int QG>
struct AttnState {
  f32x4 o[4][QG];
  float m[QG], l[QG];
  bf16x8 q[QG][DKS];
};

template <int DKS, int QG, int MASK>
__device__ __forceinline__ void attn_chunk(AttnState<DKS, QG>& st, const bfraw* __restrict__ kbase, int ldk, const bfraw* __restrict__ vtbase, int ldv,
                                           int r16, int q4, int qpos0, int kpos0, const float* __restrict__ rpbrow, int qcol0, int kcol0) {
  bf16x8 kf[2][DKS];
#pragma unroll
  for (int kt = 0; kt < 2; ++kt)
#pragma unroll
    for (int ks = 0; ks < DKS; ++ks) kf[kt][ks] = *(const bf16x8*)(kbase + (kt * 16 + r16) * ldk + ks * 32 + q4 * 8);
  bf16x8 vf[4];
#pragma unroll
  for (int dt = 0; dt < 4; ++dt) {
    const bfraw* vp = vtbase + (dt * 16 + r16) * ldv + q4 * 4;
    const uint2 a = *(const uint2*)vp;
    const uint2 b = *(const uint2*)(vp + 16);
    uint4 u; u.x = a.x; u.y = a.y; u.z = b.x; u.w = b.y;
    vf[dt] = __builtin_bit_cast(bf16x8, u);
  }
#pragma unroll
  for (int g = 0; g < QG; ++g) {
    f32x4 s[2];
#pragma unroll
    for (int kt = 0; kt < 2; ++kt) {
      s[kt] = f32x4{0.f, 0.f, 0.f, 0.f};
#pragma unroll
      for (int ks = 0; ks < DKS; ++ks) s[kt] = mfma16(kf[kt][ks], st.q[g][ks], s[kt]);
    }
    if (MASK == 1) {
      const int qp = qpos0 + g * 16 + r16;
#pragma unroll
      for (int kt = 0; kt < 2; ++kt)
#pragma unroll
        for (int r = 0; r < 4; ++r) {
          const int kp = kpos0 + kt * 16 + q4 * 4 + r;
          const int d = qp - kp;
          if (d > 128 || d < -128) s[kt][r] = -1e30f;
        }
    } else if (MASK == 2) {
      const int qc = qcol0 + r16;
      int cs = qc - 8; cs = cs < 0 ? 0 : (cs > 48 ? 48 : cs);
#pragma unroll
      for (int kt = 0; kt < 2; ++kt)
#pragma unroll
        for (int r = 0; r < 4; ++r) {
          const int kc = kcol0 + kt * 16 + q4 * 4 + r;
          int dc = kc - qc + 15; dc = dc < 0 ? 0 : (dc > 30 ? 30 : dc);
          const bool valid = (kc >= cs) && (kc < cs + 16);
          s[kt][r] = valid ? s[kt][r] + rpbrow[dc] * LOG2E : -1e30f;
        }
    }
    const float mref = st.m[g];
    float ps = 0.f;
    f32x4 p0, p1;
#pragma unroll
    for (int r = 0; r < 4; ++r) { p0[r] = __builtin_amdgcn_exp2f(s[0][r] - mref); p1[r] = __builtin_amdgcn_exp2f(s[1][r] - mref); ps += p0[r] + p1[r]; }
    st.l[g] += ps;
    uint4 u;
    u.x = pack2(p0[0], p0[1]); u.y = pack2(p0[2], p0[3]); u.z = pack2(p1[0], p1[1]); u.w = pack2(p1[2], p1[3]);
    const bf16x8 pf = __builtin_bit_cast(bf16x8, u);
#pragma unroll
    for (int dt = 0; dt < 4; ++dt) st.o[dt][g] = mfma16(vf[dt], pf, st.o[dt][g]);
  }
}

template <int DKS, int QG>
__device__ __forceinline__ void attn_init(AttnState<DKS, QG>& st, const bfraw* __restrict__ qbase, int ldq, int r16, int q4, bool has_sink, float sinkv,
                                          float kbound, float bias_bound) {
#pragma unroll
  for (int g = 0; g < QG; ++g) {
#pragma unroll
    for (int ks = 0; ks < DKS; ++ks) st.q[g][ks] = *(const bf16x8*)(qbase + (size_t)(g * 16 + r16) * ldq + ks * 32 + q4 * 8);
#pragma unroll
    for (int dt = 0; dt < 4; ++dt) st.o[dt][g] = f32x4{0.f, 0.f, 0.f, 0.f};
    float qq = 0.f;
#pragma unroll
    for (int ks = 0; ks < DKS; ++ks)
#pragma unroll
      for (int e = 0; e < 8; ++e) { const float x = (float)st.q[g][ks][e]; qq += x * x; }
    qq = quad_sum(qq);
    float mref = sqrtf(qq) * kbound + bias_bound;
    if (has_sink) mref = fmaxf(mref, sinkv * LOG2E);
    st.m[g] = mref;
    st.l[g] = (has_sink && q4 == 0) ? __builtin_amdgcn_exp2f(sinkv * LOG2E - mref) : 0.f;
  }
}

template <int DKS, int QG>
__device__ __forceinline__ void attn_finish(AttnState<DKS, QG>& st, const bfraw* __restrict__ gate, int ldg, bfraw* __restrict__ Y, int tok0, int r16, int q4) {
#pragma unroll
  for (int g = 0; g < QG; ++g) {
    const float l = quad_sum(st.l[g]);
    const float inv = 1.f / l;
    const int tok = tok0 + g * 16 + r16;
#pragma unroll
    for (int dt = 0; dt < 4; ++dt) {
      const uint2 gu = *(const uint2*)(gate + (size_t)tok * ldg + dt * 16 + q4 * 4);
      f32x4 v;
      v[0] = st.o[dt][g][0] * inv * bf2f(gu.x & 0xffffu);
      v[1] = st.o[dt][g][1] * inv * bf2f(gu.x >> 16);
      v[2] = st.o[dt][g][2] * inv * bf2f(gu.y & 0xffffu);
      v[3] = st.o[dt][g][3] * inv * bf2f(gu.y >> 16);
      *(uint2*)(Y + (size_t)tok * 1024 + dt * 16 + q4 * 4) = pack4(v);
    }
  }
}

template <int QG>
__device__ __forceinline__ void gate_load(uint2 (&gu)[QG][4], const bfraw* __restrict__ gate, int ldg, int tok0, int r16, int q4) {
#pragma unroll
  for (int g = 0; g < QG; ++g)
#pragma unroll
    for (int dt = 0; dt < 4; ++dt) gu[g][dt] = *(const uint2*)(gate + (size_t)(tok0 + g * 16 + r16) * ldg + dt * 16 + q4 * 4);
}
template <int DKS, int QG>
__device__ __forceinline__ void attn_finish_g(AttnState<DKS, QG>& st, const uint2 (&gu)[QG][4], bfraw* __restrict__ Y, int tok0, int r16, int q4) {
#pragma unroll
  for (int g = 0; g < QG; ++g) {
    const float inv = 1.f / quad_sum(st.l[g]);
    const int tok = tok0 + g * 16 + r16;
#pragma unroll
    for (int dt = 0; dt < 4; ++dt) {
      f32x4 v;
      v[0] = st.o[dt][g][0] * inv * bf2f(gu[g][dt].x & 0xffffu);
      v[1] = st.o[dt][g][1] * inv * bf2f(gu[g][dt].x >> 16);
      v[2] = st.o[dt][g][2] * inv * bf2f(gu[g][dt].y & 0xffffu);
      v[3] = st.o[dt][g][3] * inv * bf2f(gu[g][dt].y >> 16);
      *(uint2*)(Y + (size_t)tok * 1024 + dt * 16 + q4 * 4) = pack4(v);
    }
  }
}

#define VSTR 72
template <int DKS>
struct KVStage {
  static constexpr int KSTR = DKS * 32 + 16;
  static constexpr int BUF = 64 * KSTR + 64 * VSTR;
  static constexpr int NKC = 64 * DKS * 4;
  static constexpr int NRK = (NKC + NT - 1) / NT;
};
template <int DKS>
__device__ __forceinline__ void kv_gload(uint4& k0, uint4& k1, uint4& v, const bfraw* __restrict__ Kp, int ldk, const bfraw* __restrict__ Vt, int tid) {
  { const int c = tid; const int row = c / (DKS * 4), kc = c % (DKS * 4); k0 = *(const uint4*)(Kp + (size_t)row * ldk + kc * 8); }
  if (KVStage<DKS>::NRK > 1) {
    int c = tid + NT; if (c >= KVStage<DKS>::NKC) c = KVStage<DKS>::NKC - 1;
    const int row = c / (DKS * 4), kc = c % (DKS * 4);
    k1 = *(const uint4*)(Kp + (size_t)row * ldk + kc * 8);
  }
  { const int row = tid >> 3, kc = tid & 7; v = *(const uint4*)(Vt + row * 64 + kc * 8); }
}
template <int DKS>
__device__ __forceinline__ void kv_lstore(const uint4& k0, const uint4& k1, const uint4& v, bfraw* buf, int tid) {
  constexpr int KSTR = KVStage<DKS>::KSTR;
  bfraw* lk = buf; bfraw* lv = buf + 64 * KSTR;
  { const int c = tid; const int row = c / (DKS * 4), kc = c % (DKS * 4); *(uint4*)(lk + row * KSTR + kc * 8) = k0; }
  if (KVStage<DKS>::NRK > 1) {
    const int c = tid + NT;
    if (c < KVStage<DKS>::NKC) { const int row = c / (DKS * 4), kc = c % (DKS * 4); *(uint4*)(lk + row * KSTR + kc * 8) = k1; }
  }
  { const int row = tid >> 3, kc = tid & 7; *(uint4*)(lv + row * VSTR + kc * 8) = v; }
}

template <int DKS, class TokF, class CompF>
__device__ __forceinline__ void kv_pipeline(int N, TokF tokOf, CompF compute, const bfraw* __restrict__ Kp, int ldk, const bfraw* __restrict__ Vt, bfraw* lds, int tid) {
  constexpr int BUF = KVStage<DKS>::BUF;
  uint4 kA0, kA1 = {0u, 0u, 0u, 0u}, vA, kB0, kB1 = {0u, 0u, 0u, 0u}, vB;
  __syncthreads();
  { const int t0 = tokOf(0); kv_gload<DKS>(kA0, kA1, vA, Kp + (size_t)t0 * ldk, ldk, Vt + (size_t)(t0 >> 6) * 4096, tid); }
  kv_lstore<DKS>(kA0, kA1, vA, lds, tid);
  { const int t1 = tokOf(N > 1 ? 1 : 0); kv_gload<DKS>(kA0, kA1, vA, Kp + (size_t)t1 * ldk, ldk, Vt + (size_t)(t1 >> 6) * 4096, tid); }
  __syncthreads();
  for (int c = 0; c < N; c += 2) {
    { const int cn = (c + 2 < N) ? c + 2 : N - 1; const int tk = tokOf(cn); kv_gload<DKS>(kB0, kB1, vB, Kp + (size_t)tk * ldk, ldk, Vt + (size_t)(tk >> 6) * 4096, tid); }
    compute(c, lds, lds + 64 * KVStage<DKS>::KSTR);
    kv_lstore<DKS>(kA0, kA1, vA, lds + BUF, tid);
    __syncthreads();
    { const int cn = (c + 3 < N) ? c + 3 : N - 1; const int tk = tokOf(cn); kv_gload<DKS>(kA0, kA1, vA, Kp + (size_t)tk * ldk, ldk, Vt + (size_t)(tk >> 6) * 4096, tid); }
    if (c + 1 < N) compute(c + 1, lds + BUF, lds + BUF + 64 * KVStage<DKS>::KSTR);
    kv_lstore<DKS>(kB0, kB1, vB, lds, tid);
    __syncthreads();
  }
}

template <int DKS, bool WINDOW, int QG>
__device__ __forceinline__ void attn_block(const bfraw* __restrict__ Q, int ldq, const bfraw* __restrict__ Kp, int ldk, const bfraw* __restrict__ Vt,
                                           const bfraw* __restrict__ gate, int ldg, bfraw* __restrict__ Y,
                                           int qtok0, int s1tok, int n1, int s2tok, int n2, bool has_sink, float sinkv, int qpos_w, int kpos1, bfraw* lds, float kbound) {
  const int tid = phase_tid(), lane = tid & 63, wave = tid >> 6;
  const int r16 = lane & 15, q4 = lane >> 4;
  constexpr int KSTR = KVStage<DKS>::KSTR, BUF = KVStage<DKS>::BUF;
  AttnState<DKS, QG> st;
  const int qtok_w = qtok0 + wave * (16 * QG);
  attn_init<DKS, QG>(st, Q + (size_t)qtok_w * ldq, ldq, r16, q4, has_sink, sinkv, kbound, 0.f);
  uint2 gu[QG][4];
  gate_load<QG>(gu, gate, ldg, qtok_w, r16, q4);
  const int N = n1 + n2;
  kv_pipeline<DKS>(N,
    [&](int c) { return (c < n1) ? s1tok + c * 64 : s2tok + (c - n1) * 64; },
    [&](int c, const bfraw* bk, const bfraw* bv) {
#pragma unroll 1
      for (int sub = 0; sub < 2; ++sub) {
        if (WINDOW && c < n1) {
          const int kp = kpos1 + c * 64 + sub * 32;
          if (!(kp + 31 < qpos_w - 128 || kp > qpos_w + (16 * QG - 1) + 128))
            attn_chunk<DKS, QG, 1>(st, bk + sub * 32 * KSTR, KSTR, bv + sub * 32, VSTR, r16, q4, qpos_w, kp, nullptr, 0, 0);
        } else {
          attn_chunk<DKS, QG, 0>(st, bk + sub * 32 * KSTR, KSTR, bv + sub * 32, VSTR, r16, q4, 0, 0, nullptr, 0, 0);
        }
      }
    }, Kp, ldk, Vt, lds, tid);
  attn_finish_g<DKS, QG>(st, gu, Y, qtok_w, r16, q4);
}

__device__ __forceinline__ void phase_attn0(const Params& p, unsigned char* ldsraw) {
  bfraw* lds = (bfraw*)ldsraw;
  const bfraw* AX = (const bfraw*)(p.ws + WS_AX);
  const bfraw* VT = (const bfraw*)(p.ws + WS_VT);
  const bfraw* QA = (const bfraw*)(p.ws + WS_QA);
  const bfraw* KA = (const bfraw*)(p.ws + WS_KA);
  bfraw* Y = (bfraw*)(p.ws + WS_HY);
  const float* kmax = (const float*)(p.ws + WS_KMAX);
  const int tid = phase_tid(), lane = tid & 63, wave = tid >> 6;
  const int r16 = lane & 15, q4 = lane >> 4;
  if (__builtin_amdgcn_readfirstlane(tid) >= 256) __builtin_amdgcn_s_setprio(1);
  constexpr int N_LA = 128, N_NB = 128, N_CA = 256, N_CB = 256;
  constexpr int E_LA = N_LA, E_NB = E_LA + N_NB, E_CA = E_NB + N_CA, E_CB = E_CA + N_CB;
  for (int it = blockIdx.x; it < E_CB; it += gridDim.x) {
    if (it < E_LA) {
      const int qb = it & 7, h = (it >> 3) & 7, b = it >> 6;
      attn_block<3, false, 1>(QA + h * 96, 768, KA + (size_t)h * TP * 96, 96, VT + (size_t)(8 + h) * VCHUNKS * 4096, AX + C0_GA + h * 64, LD0, Y + h * 64,
                           T_CTX + b * 1024 + qb * 128, T_CTX + b * 1024, 16, T_ALL + b * 256, 4, false, 0.f, 0, 0, lds, kmax[1]);
    } else if (it < E_NB) {
      const int j2 = it - E_LA;
      const int rp = j2 & 7, h = (j2 >> 3) & 7, b = j2 >> 6;
      const int jb = wave & 3, rrow = rp * 2 + (wave >> 2);
      const int qtok0 = T_CTX + b * 1024 + rrow * 64 + jb * 16;
      constexpr int KSTR = KVStage<2>::KSTR, BUF = KVStage<2>::BUF;
      AttnState<2, 1> st;
      attn_init<2, 1>(st, AX + (size_t)qtok0 * LD0 + C0_QB + h * 64, LD0, r16, q4, false, 0.f, fmaxf(kmax[0], kmax[8 + b * 8 + h]), kmax[4] * LOG2E);
      int rs = rrow - 4; rs = rs < 0 ? 0 : (rs > 8 ? 8 : rs);
      int lo = rp * 2 - 4; lo = lo < 0 ? 0 : (lo > 8 ? 8 : lo);
      int hi = rp * 2 + 1 - 4; hi = hi < 0 ? 0 : (hi > 8 ? 8 : hi); hi += 7;
      const int nrows = hi - lo + 1;
      int cst = jb * 16 - 8; cst = cst < 0 ? 0 : (cst > 32 ? 32 : cst);
      const float* rpb = p.in[I_RPB] + h * (15 * 31);
      const bfraw* Kp = (const bfraw*)(p.ws + WS_KH) + (size_t)h * TP * 64;
      const bfraw* Vp = VT + (size_t)h * VCHUNKS * 4096;
      const int lat0 = T_CTX + b * 1024 + lo * 64;
      const int N = nrows + 4;
      kv_pipeline<2>(N,
        [&](int c) { return (c < nrows) ? lat0 + c * 64 : T_ALL + b * 256 + (c - nrows) * 64; },
        [&](int c, const bfraw* bk, const bfraw* bv) {
          if (c < nrows) {
            const int krow = lo + c;
            if (krow >= rs && krow < rs + 8) {
              const int dr = krow - rrow + 7;
              attn_chunk<2, 1, 2>(st, bk + cst * KSTR, KSTR, bv + cst, VSTR, r16, q4, 0, 0, rpb + dr * 31, jb * 16, cst);
            }
          } else {
            attn_chunk<2, 1, 0>(st, bk, KSTR, bv, VSTR, r16, q4, 0, 0, nullptr, 0, 0);
            attn_chunk<2, 1, 0>(st, bk + 32 * KSTR, KSTR, bv + 32, VSTR, r16, q4, 0, 0, nullptr, 0, 0);
          }
        }, Kp, 64, Vp, lds, tid);
      attn_finish<2, 1>(st, AX + C0_GB + h * 64, LD0, Y + 512 + h * 64, qtok0, r16, q4);
    } else if (it < E_CA) {
      const int j2 = it - E_NB;
      const int h = j2 & 7, b = j2 >> 3;
      attn_block<3, false, 2>(QA + h * 96, 768, KA + (size_t)h * TP * 96, 96, VT + (size_t)(8 + h) * VCHUNKS * 4096, AX + C0_GA + h * 64, LD0, Y + h * 64,
                           b * 256, b * 256, 4, 0, 0, false, 0.f, 0, 0, lds, kmax[1]);
    } else {
      const int j2 = it - E_CA;
      const int h = j2 & 7, b = j2 >> 3;
      attn_block<2, false, 2>(AX + C0_QB + h * 64, LD0, (const bfraw*)(p.ws + WS_KH) + (size_t)h * TP * 64, 64, VT + (size_t)h * VCHUNKS * 4096, AX + C0_GB + h * 64, LD0, Y + 512 + h * 64,
                           b * 256, b * 256, 4, 0, 0, false, 0.f, 0, 0, lds, kmax[0]);
    }
  }
  __builtin_amdgcn_s_setprio(0);
}

__device__ __forceinline__ void phase_attn1(const Params& p, unsigned char* ldsraw) {
  bfraw* lds = (bfraw*)ldsraw;
  const bfraw* AX = (const bfraw*)(p.ws + WS_AX);
  const bfraw* VT = (const bfraw*)(p.ws + WS_VT);
  bfraw* Y = (bfraw*)(p.ws + WS_HY);
  const float* kmax = (const float*)(p.ws + WS_KMAX);
  const int wave = phase_tid() >> 6;
  if (__builtin_amdgcn_readfirstlane(wave) >= 4) __builtin_amdgcn_s_setprio(1);
  constexpr int N_LC = 128, N_LD = 128, N_CC = 256, N_CD = 256;
  constexpr int E_LC = N_LC, E_LD = E_LC + N_LD, E_CC = E_LD + N_CC, E_CD = E_CC + N_CD;
  const float* sink = p.in[I_SINK];
  for (int it = blockIdx.x; it < E_CD; it += gridDim.x) {
    if (it < E_LC) {
      const int qb = it & 7, h = (it >> 3) & 7, b = it >> 6;
      const int kv = h >> 2;
      attn_block<2, false, 1>(AX + C1_QC + h * 64, LD1, (const bfraw*)(p.ws + WS_KH) + (size_t)kv * TP * 64, 64, VT + (size_t)kv * VCHUNKS * 4096, AX + C1_GC + h * 64, LD1, Y + h * 64,
                           T_CTX + b * 1024 + qb * 128, T_CTX + b * 1024, 16, T_ALL + b * 256, 4, false, 0.f, 0, 0, lds, fmaxf(kmax[2], kmax[24 + b * 2 + kv]));
    } else if (it < E_LD) {
      const int j2 = it - E_LC;
      const int qb = j2 & 7, h = (j2 >> 3) & 7, b = j2 >> 6;
      const int kv = h >> 2;
      const int q0 = qb * 128;
      int klo = q0 - 128; klo = klo < 0 ? 0 : klo;
      int khi = q0 + 256; khi = khi > 1024 ? 1024 : khi;
      attn_block<2, true, 1>(AX + C1_QD + h * 64, LD1, (const bfraw*)(p.ws + WS_KH) + (size_t)(2 + kv) * TP * 64, 64, VT + (size_t)(2 + kv) * VCHUNKS * 4096, AX + C1_GD + h * 64, LD1, Y + 512 + h * 64,
                          T_CTX + b * 1024 + q0, T_CTX + b * 1024 + klo, (khi - klo) >> 6, T_ALL + b * 256, 4, true, sink[h], q0 + wave * 16, klo, lds, fmaxf(kmax[3], kmax[28 + b * 2 + kv]));
    } else if (it < E_CC) {
      const int j2 = it - E_LD;
      const int h = j2 & 7, b = j2 >> 3;
      const int kv = h >> 2;
      attn_block<2, false, 2>(AX + C1_QC + h * 64, LD1, (const bfraw*)(p.ws + WS_KH) + (size_t)kv * TP * 64, 64, VT + (size_t)kv * VCHUNKS * 4096, AX + C1_GC + h * 64, LD1, Y + h * 64,
                           b * 256, b * 256, 4, 0, 0, false, 0.f, 0, 0, lds, kmax[2]);
    } else {
      const int j2 = it - E_CC;
      const int h = j2 & 7, b = j2 >> 3;
      const int kv = h >> 2;
      attn_block<2, false, 2>(AX + C1_QD + h * 64, LD1, (const bfraw*)(p.ws + WS_KH) + (size_t)(2 + kv) * TP * 64, 64, VT + (size_t)(2 + kv) * VCHUNKS * 4096, AX + C1_GD + h * 64, LD1, Y + 512 + h * 64,
                           b * 256, b * 256, 4, 0, 0, true, sink[h], 0, 0, lds, kmax[3]);
    }
  }
  __builtin_amdgcn_s_setprio(0);
}

#define XB_TMO      128
#define XB_XCNT(j)  (256  + 64 * (j))
#define XB_XSUB(j)  (1280 + 64 * (j))
#define XB_XGEN(j)  (2304 + 64 * (j))
#define XB_TOP      3328
#define XB_TOPGEN   3392
#define XCD_BAR_WORDS 3456
#define XB_SPIN_CAP (1u << 22)
#define LAS __attribute__((address_space(3)))
__device__ __forceinline__ unsigned xb_ld(unsigned* p)              { return __hip_atomic_load(p, __ATOMIC_RELAXED, __HIP_MEMORY_SCOPE_AGENT); }
__device__ __forceinline__ unsigned xb_add(unsigned* p, unsigned v) { return __hip_atomic_fetch_add(p, v, __ATOMIC_RELAXED, __HIP_MEMORY_SCOPE_AGENT); }
__device__ __forceinline__ unsigned xb_xcc_id() { return (unsigned)__builtin_amdgcn_s_getreg((3 << 11) | 20) & 0xFu; }
#define XB_SPIN(cond, bar) do { unsigned _sp = 0; while (cond) { __builtin_amdgcn_s_sleep(1); \
    if ((++_sp & 255u) == 0u) { if (xb_ld(&(bar)[XB_TMO])) break; if (_sp > XB_SPIN_CAP) { atomicAdd(&(bar)[XB_TMO], 1u); break; } } } } while (0)
struct XcdBarrier { unsigned* bar; unsigned x; volatile LAS unsigned* st; };
__device__ __forceinline__ XcdBarrier xcd_barrier_post(unsigned* bar, volatile LAS unsigned* st) {
  XcdBarrier b; b.bar = bar; b.x = xb_xcc_id(); b.st = st;
  if (threadIdx.x == 0) (void)xb_add(&bar[XB_XCNT(b.x)], 1u);
  return b;
}
__device__ __forceinline__ void xcd_barrier_complete(unsigned* bar, unsigned x, unsigned& nloc, unsigned& nx) {
  const unsigned G = gridDim.x * gridDim.y * gridDim.z;
  unsigned sum, cnt, mine, sp = 0u;
  for (;;) {
    sum = 0u; cnt = 0u; mine = 0u;
#pragma unroll
    for (unsigned j = 0; j < 16; ++j) { const unsigned c = xb_ld(&bar[XB_XCNT(j)]); sum += c; cnt += (c > 0u) ? 1u : 0u; mine = (j == x) ? c : mine; }
    if (sum == G) break;
    __builtin_amdgcn_s_sleep(1);
    if ((++sp & 255u) == 0u) { if (xb_ld(&bar[XB_TMO])) break; if (sp > XB_SPIN_CAP) { atomicAdd(&bar[XB_TMO], 1u); break; } }
  }
  nloc = mine > 0u ? mine : 1u; nx = cnt > 0u ? cnt : 1u;
}
__device__ __forceinline__ void xcd_barrier(const XcdBarrier& b) {
  asm volatile("s_waitcnt vmcnt(0)" ::: "memory");
  __syncthreads();
  if (threadIdx.x == 0) {
    unsigned* bar = b.bar;
    __builtin_amdgcn_s_waitcnt(0);
    unsigned nloc = b.st[0], nx = b.st[1];
    if (nloc == 0u) { xcd_barrier_complete(bar, b.x, nloc, nx); b.st[0] = nloc; b.st[1] = nx; }
    const unsigned old = xb_add(&bar[XB_XSUB(b.x)], 1u);
    const unsigned gen = old / nloc;
    if (old + 1u == (gen + 1u) * nloc) {
      __builtin_amdgcn_fence(__ATOMIC_RELEASE, "agent");
      asm volatile("s_waitcnt vmcnt(0)" ::: "memory");
      const unsigned og = xb_add(&bar[XB_TOP], 1u);
      const unsigned tg = og / nx;
      if (og + 1u == (tg + 1u) * nx) xb_add(&bar[XB_TOPGEN], 1u);
      else XB_SPIN(xb_ld(&bar[XB_TOPGEN]) == tg, bar);
      __builtin_amdgcn_fence(__ATOMIC_ACQUIRE, "agent");
      xb_add(&bar[XB_XGEN(b.x)], 1u);
      asm volatile("s_waitcnt vmcnt(0)" ::: "memory");
    } else {
      XB_SPIN(xb_ld(&bar[XB_XGEN(b.x)]) == gen, bar);
      __builtin_amdgcn_fence(__ATOMIC_ACQUIRE, "agent");
      asm volatile("s_waitcnt vmcnt(0)" ::: "memory");
    }
  }
  __syncthreads();
}

__device__ __forceinline__ void run_phase(const Params& p, int ph, unsigned char* lds) {
  switch (ph) {
    case 0: phase_prep0(p, lds); break;
    case 1: phase_modulate(p, 0, lds); break;
    case 2: phase_gemm_in0(p, lds); break;
    case 3: phase_up0(p, lds); break;
    case 4: phase_attn0(p, lds); break;
    case 5: phase_gemm_out(p, 0, lds); break;
    case 6: phase_modulate(p, 1, lds); break;
    case 7: phase_gemm_in1(p, lds); break;
    case 8: phase_attn1(p, lds); break;
    case 9: phase_gemm_out(p, 1, lds); break;
  }
}

__device__ __forceinline__ const Params* launder_params(const Params* q) { asm volatile("" : "+s"(q) :: "memory"); return q; }

#if MULTI_LAUNCH
template <int PH>
__global__ void __launch_bounds__(NT, 2) k_phase(Params p) {
  __shared__ __attribute__((aligned(16))) unsigned char lds[LDS_BYTES];
  run_phase(p, PH, lds);
}
template <int PH>
static void launch_phases(const Params& p, hipStream_t stream) {
  hipLaunchKernelGGL(k_phase<PH>, dim3(256), dim3(NT), 0, stream, p);
  if constexpr (PH < 9) launch_phases<PH + 1>(p, stream);
}
#else
__global__ void __launch_bounds__(NT, 2) k_mega(Params p) {
  __shared__ __attribute__((aligned(16))) unsigned char lds[LDS_BYTES];
  __shared__ uint4 xb_words;
  cg::grid_group grid = cg::this_grid();
  if (threadIdx.x == 0) xb_words = make_uint4(0u, 0u, 0u, 0u);
  __syncthreads();
  XcdBarrier xb = xcd_barrier_post((unsigned*)(p.ws + WS_BAR), (volatile LAS unsigned*)&xb_words);
#define SEAM() do { if (p.sync_mode) grid.sync(); else xcd_barrier(xb); } while (0)
#ifndef DUP_PHASE
#define DUP_PHASE -1
#endif
#define PP p
#define RUN(ph, call) do { call; SEAM(); if (DUP_PHASE == ph) { call; SEAM(); } } while (0)
  RUN(0, phase_prep0(PP, lds));
  RUN(1, phase_modulate(PP, 0, lds));
  RUN(2, phase_gemm_in0(PP, lds));
  RUN(3, phase_up0(PP, lds));
  RUN(4, phase_attn0(PP, lds));
  RUN(5, phase_gemm_out(PP, 0, lds));
  RUN(6, phase_modulate(PP, 1, lds));
  RUN(7, phase_gemm_in1(PP, lds));
  RUN(8, phase_attn1(PP, lds));
  phase_gemm_out(PP, 1, lds);
  if (DUP_PHASE == 9) { SEAM(); phase_gemm_out(PP, 1, lds); }
}
#endif

extern "C" void kernel_launch(void* const* d_in, const int* in_sizes, int n_in, void* d_out, int out_size, void* d_ws, size_t ws_size,
                              hipStream_t stream) {
  Params p{};
  for (int i = 0; i < 33; ++i) p.in[i] = (const float*)d_in[i];
  p.out = (float*)d_out;
  p.ws = (unsigned char*)d_ws;
  if (ws_size < WS_END) { fprintf(stderr, "workspace too small: %zu < %llu\n", ws_size, (unsigned long long)WS_END); return; }
#if MULTI_LAUNCH
  launch_phases<0>(p, stream);
#else
  static int grid_blocks = 0;
  if (!grid_blocks) {
    int dev = 0, cus = 0, per_cu = 0;
    (void)hipGetDevice(&dev);
    (void)hipDeviceGetAttribute(&cus, hipDeviceAttributeMultiprocessorCount, dev);
    (void)hipOccupancyMaxActiveBlocksPerMultiprocessor(&per_cu, k_mega, NT, 0);
    per_cu = 1;
    grid_blocks = cus * per_cu;
  }
  void* args[] = {&p};
  (void)hipMemsetAsync((unsigned char*)d_ws + WS_BAR, 0, XCD_BAR_WORDS * 4, stream);
  hipError_t e = hipLaunchCooperativeKernel((void*)k_mega, dim3(grid_blocks), dim3(NT), args, 0, stream);
  if (e != hipSuccess) fprintf(stderr, "cooperative launch failed: %s (grid %d)\n", hipGetErrorString(e), grid_blocks);
#endif
}
```
